# Optimizing an MI355X kernel written in HIP

```python
import jax, jax.numpy as jnp
from jax import lax
import numpy as np

D_MODEL = 1024
BATCH = 8
SEQ = 4096
DEPTH = 4

N_MIXERS = 2
EXPAND = 2
D_INNER = EXPAND * D_MODEL
CONV_WIDTH = 3
HEAD_DIM = 128
N_HEADS = D_INNER // HEAD_DIM
CHUNK = 32
EPS = 1e-6
LB_FLOOR = 1e-30
N_CONV_LAYERS = (DEPTH + N_MIXERS - 1) // N_MIXERS
N_HGRN_LAYERS = (DEPTH + N_MIXERS - 2) // N_MIXERS

kernel_name = "bidir_shortconv_hgrn2_interleaved_trunk"


def rms_norm(x, w):
    xf = x.astype(jnp.float32)
    xf = xf * lax.rsqrt(jnp.mean(xf * xf, axis=-1, keepdims=True) + EPS)
    return (xf * w.astype(jnp.float32)).astype(x.dtype)


def short_conv_mixer(h, w_in, conv_k, w_out):
    proj = h @ w_in
    b_gate, c_gate, u, z = jnp.split(proj, 4, axis=-1)
    v = c_gate * u
    v = lax.conv_general_dilated(
        v, conv_k[:, None, :].astype(v.dtype), window_strides=(1,),
        padding=((CONV_WIDTH // 2, CONV_WIDTH // 2),),
        dimension_numbers=("NWC", "WIO", "NWC"),
        feature_group_count=D_INNER)
    y = b_gate * v * jax.nn.silu(z)
    return y @ w_out


def gla_chunk_scan(q, k, v, log_f):
    bsz, nh, seq, dk = q.shape
    dv = v.shape[-1]
    n_chunks = seq // CHUNK

    def to_chunks(a):
        return jnp.moveaxis(a.reshape(bsz, nh, n_chunks, CHUNK, a.shape[-1]), 2, 0)

    causal_in_chunk = jnp.tril(jnp.ones((CHUNK, CHUNK), dtype=bool))[:, :, None]

    def step(state, inp):
        qc, kc, vc, gc = inp
        g_cum = jnp.cumsum(gc, axis=2)
        o_inter = jnp.einsum("bhtk,bhkv->bhtv", qc * jnp.exp(g_cum), state)
        diff = g_cum[:, :, :, None, :] - g_cum[:, :, None, :, :]
        decay = jnp.where(causal_in_chunk, jnp.exp(jnp.where(causal_in_chunk, diff, 0.0)), 0.0)
        scores = jnp.einsum("bhtsk,bhsk->bhts", qc[:, :, :, None, :] * decay, kc)
        o_intra = jnp.einsum("bhts,bhsv->bhtv", scores, vc)
        g_last = g_cum[:, :, -1:, :]
        new_state = (jnp.exp(g_last[:, :, 0, :])[..., None] * state
                     + jnp.einsum("bhsk,bhsv->bhkv", kc * jnp.exp(g_last - g_cum), vc))
        return new_state, o_inter + o_intra

    s0 = jnp.zeros((bsz, nh, dk, dv), jnp.float32)
    _, o = lax.scan(step, s0, (to_chunks(q), to_chunks(k), to_chunks(v), to_chunks(log_f)))
    return jnp.moveaxis(o, 0, 2).reshape(bsz, nh, seq, dv)


def hgrn_lower_bounds(lb_logits):
    p = jax.nn.softmax(lb_logits.astype(jnp.float32), axis=0)
    return jnp.cumsum(p, axis=0) - p[0]


def hgrn2_mixer(h, w_in, lb, norm_w, w_out):
    bsz, seq, _ = h.shape
    proj = h @ w_in
    q, f_fw, f_bw, i_val, z = jnp.split(proj, 5, axis=-1)
    lb = jnp.clip(lb, 0.0, 1.0 - 1e-6)
    log_lb = jnp.log(jnp.maximum(lb, LB_FLOOR))
    log_1m_lb = jnp.log1p(-lb)

    def heads(a):
        return a.astype(jnp.float32).reshape(bsz, seq, N_HEADS, HEAD_DIM).transpose(0, 2, 1, 3)

    def gates(f_pre):
        fp = f_pre.astype(jnp.float32)
        log_f = jnp.logaddexp(log_lb, log_1m_lb + jax.nn.log_sigmoid(fp))
        key = (1.0 - lb) * jax.nn.sigmoid(-fp)
        return heads(key), heads(log_f)

    qh = heads(q) * (HEAD_DIM ** -0.5)
    vh = heads(i_val)
    k_fw, lf_fw = gates(f_fw)
    k_bw, lf_bw = gates(f_bw)
    o_fw = gla_chunk_scan(qh, k_fw, vh, lf_fw)
    flip = lambda a: jnp.flip(a, axis=2)
    o_bw = flip(gla_chunk_scan(flip(qh), flip(k_bw), flip(vh), flip(lf_bw)))
    o = o_fw + o_bw
    o = o * lax.rsqrt(jnp.mean(o * o, axis=-1, keepdims=True) + EPS)
    o = o.transpose(0, 2, 1, 3).reshape(bsz, seq, D_INNER) * norm_w.astype(jnp.float32)
    y = o.astype(h.dtype) * jax.nn.silu(z)
    return y @ w_out


def setup_inputs(seed: int = 0) -> dict:
    key = jax.random.key(seed)
    ks = jax.random.split(key, 10)
    nrm = jax.random.normal
    f32 = jnp.float32
    x = nrm(ks[0], (BATCH, SEQ, D_MODEL), f32)
    norm_w = 1.0 + 0.02 * nrm(ks[1], (DEPTH, D_MODEL), f32)
    final_norm_w = 1.0 + 0.02 * nrm(ks[2], (D_MODEL,), f32)
    conv_w_in = nrm(ks[3], (N_CONV_LAYERS, D_MODEL, 4 * D_INNER), f32) * D_MODEL ** -0.5
    conv_kernel = nrm(ks[4], (N_CONV_LAYERS, CONV_WIDTH, D_INNER), f32) * CONV_WIDTH ** -0.5
    conv_w_out = nrm(ks[5], (N_CONV_LAYERS, D_INNER, D_MODEL), f32) * D_INNER ** -0.5
    hgrn_w_in = nrm(ks[6], (N_HGRN_LAYERS, D_MODEL, 5 * D_INNER), f32) * D_MODEL ** -0.5
    hgrn_lb_logits = 0.1 * nrm(ks[7], (N_HGRN_LAYERS, D_INNER), f32)
    hgrn_norm_w = 1.0 + 0.02 * nrm(ks[8], (N_HGRN_LAYERS, D_INNER), f32)
    hgrn_w_out = nrm(ks[9], (N_HGRN_LAYERS, D_INNER, D_MODEL), f32) * D_INNER ** -0.5
    return {"x": x, "norm_w": norm_w, "final_norm_w": final_norm_w,
            "conv_w_in": conv_w_in, "conv_kernel": conv_kernel, "conv_w_out": conv_w_out,
            "hgrn_w_in": hgrn_w_in, "hgrn_lb_logits": hgrn_lb_logits,
            "hgrn_norm_w": hgrn_norm_w, "hgrn_w_out": hgrn_w_out}


def reference(x, norm_w, final_norm_w, conv_w_in, conv_kernel, conv_w_out,
              hgrn_w_in, hgrn_lb_logits, hgrn_norm_w, hgrn_w_out):
    lower_bounds = hgrn_lower_bounds(hgrn_lb_logits)
    for layer in range(DEPTH):
        h = rms_norm(x, norm_w[layer])
        j = layer // N_MIXERS
        if layer % N_MIXERS == 0:
            y = short_conv_mixer(h, conv_w_in[j], conv_kernel[j], conv_w_out[j])
        else:
            y = hgrn2_mixer(h, hgrn_w_in[j], lower_bounds[j], hgrn_norm_w[j], hgrn_w_out[j])
        x = x + y
    return rms_norm(x, final_norm_w)
```

```cpp
#include <hip/hip_runtime.h>
#include <hip/hip_cooperative_groups.h>
#include <cstdio>
namespace cg = cooperative_groups;
#ifndef DBG_LAYERS
#define DBG_LAYERS 4
#endif

#define LAS __attribute__((address_space(3)))
typedef unsigned short bf16_t;
typedef short bf16x8 __attribute__((ext_vector_type(8)));
typedef short bf16x4 __attribute__((ext_vector_type(4)));
typedef float f32x4 __attribute__((ext_vector_type(4)));
typedef unsigned u32x4 __attribute__((ext_vector_type(4)));
typedef unsigned u32x2 __attribute__((ext_vector_type(2)));

constexpr int DM = 1024, EI = 2048, SEQ = 4096, NB = 8, MT = NB * SEQ  , MH = MT / 2;
constexpr float EPSV = 1e-6f;
constexpr size_t MiB = 1024ull * 1024ull;
constexpr size_t WS_XB = 0;
constexpr size_t WS_WCIN = WS_XB + 64 * MiB;
constexpr size_t WS_WCOUT = WS_WCIN + 32 * MiB;
constexpr size_t WS_WHIN = WS_WCOUT + 8 * MiB;
constexpr size_t WS_WHOUT = WS_WHIN + 40 * MiB;
constexpr size_t WS_RS = WS_WHOUT + 8 * MiB;
constexpr size_t WS_BIG = WS_RS + 2 * MiB;
constexpr size_t WS_CV = WS_BIG;
constexpr size_t WS_CG = WS_BIG + 128 * MiB;
constexpr size_t WS_QEF = WS_BIG;
constexpr size_t WS_KIF = WS_BIG + 64 * MiB;
constexpr size_t WS_QEB = WS_BIG + 128 * MiB;
constexpr size_t WS_KIB = WS_BIG + 192 * MiB;
constexpr size_t WS_VV = WS_BIG + 256 * MiB;
constexpr size_t WS_DLF = WS_BIG + 320 * MiB;
constexpr size_t WS_DLB = WS_BIG + 324 * MiB;
constexpr size_t WS_BAR = WS_BIG + 328 * MiB;
constexpr size_t WS_END = WS_BAR + 16384;

typedef __bf16 bf16v2_t __attribute__((ext_vector_type(2)));
typedef float f32x2_t __attribute__((ext_vector_type(2)));
__device__ __forceinline__ unsigned cvt_pk_bf16(float lo, float hi) { const f32x2_t v = {lo, hi}; return __builtin_bit_cast(unsigned, __builtin_convertvector(v, bf16v2_t)); }
__device__ __forceinline__ float bflo(unsigned w) { return __uint_as_float(w << 16); }
__device__ __forceinline__ float bfhi(unsigned w) { return __uint_as_float(w & 0xffff0000u); }
__device__ __forceinline__ float fast_exp2(float x) { return __builtin_amdgcn_exp2f(x); }
__device__ __forceinline__ float fast_exp(float x) { return __builtin_amdgcn_exp2f(x * 1.44269504089f); }
__device__ __forceinline__ float fast_rcp(float x) { return __builtin_amdgcn_rcpf(x); }
template <int CTRL> __device__ __forceinline__ float dppf(float x) { return __int_as_float(__builtin_amdgcn_update_dpp(0, __float_as_int(x), CTRL, 0xf, 0xf, false)); }
__device__ __forceinline__ float row_prefix16(float x) { x += dppf<0x111>(x); x += dppf<0x112>(x); x += dppf<0x114>(x); x += dppf<0x118>(x); return x; }
template <int CTRL> __device__ __forceinline__ float dppf1(float x) { return __int_as_float(__builtin_amdgcn_update_dpp(0x3f800000, __float_as_int(x), CTRL, 0xf, 0xf, false)); }
__device__ __forceinline__ float row_prefprod16(float x) { x *= dppf1<0x111>(x); x *= dppf1<0x112>(x); x *= dppf1<0x114>(x); x *= dppf1<0x118>(x); return x; }
__device__ __forceinline__ float row_sufprod16(float x) { x *= dppf1<0x101>(x); x *= dppf1<0x102>(x); x *= dppf1<0x104>(x); x *= dppf1<0x108>(x); return x; }
__device__ __forceinline__ float row_suffix16(float x) { x += dppf<0x101>(x); x += dppf<0x102>(x); x += dppf<0x104>(x); x += dppf<0x108>(x); return x; }

namespace pg8 {
constexpr int BM = 256, BK = 64, HALF = 128, HTB = HALF * BK * 2, STAGE_BYTES = 8 * HTB, NXCD = 8, WGM = 8;
__host__ __device__ __forceinline__ int lds_byte(int r, int c) { const int st = (r >> 4) * 2 + (c >> 5), rr = r & 15, cc = c & 31, ob = rr * 64 + cc * 2; return st * 1024 + (ob ^ (((ob >> 9) & 1) << 5)); }
__host__ __device__ __forceinline__ void stage_rc(int b, int& R, int& C) { const int st = b / 1024, sb = b % 1024, swz = sb ^ (((sb >> 9) & 1) << 5); R = (st >> 1) * 16 + swz / 64; C = (st & 1) * 32 + (swz % 64) / 2; }
struct Unit { int pm, pn; };
struct Gemm { const bf16_t* A; const bf16_t* Bt; int M, N, K; };
struct StaticOrder {
    int nM, nN, nwg, G, c;
    __host__ __device__ void init(int M, int N, int G_, int c_) { nM = M / BM; nN = N / BM; nwg = nM * nN; G = G_; c = c_; }
    __host__ __device__ bool next(int i, Unit& u) const {
        const long L = (long)i * G + c; if (L >= nwg) return false;
        int wgid = (int)L; { const int q = nwg / NXCD, r = nwg % NXCD, xcd = wgid % NXCD, off = wgid / NXCD; wgid = (xcd < r ? xcd * (q + 1) : r * (q + 1) + (xcd - r) * q) + off; }
        const int nig = WGM * nN, gid = wgid / nig, fm = gid * WGM, gsz = (nM - fm) < WGM ? (nM - fm) : WGM;
        u.pm = fm + ((wgid % nig) % gsz); u.pn = (wgid % nig) / gsz; return true;
    }
};
template <class Epi>
__device__ __forceinline__ void gemm_phase(LAS unsigned char* lds, const Gemm g, const StaticOrder& S, const Epi& E) {
    int tid = threadIdx.x; asm volatile("" : "+v"(tid));
    const int wid = __builtin_amdgcn_readfirstlane(tid >> 6), lane = tid & 63, wr = wid >> 2, wc = wid & 3, fr = lane & 15, fq = lane >> 4;
    const int K = g.K, nt = K / BK;
    unsigned voffA[2];
#pragma unroll
    for (int i = 0; i < 2; ++i) { int R, C; stage_rc(tid * 16 + i * 8192, R, C); voffA[i] = (unsigned)(R * K + C) * 2u; }
    const size_t kstep = (size_t)(BK * 2);
    const size_t hstep = (size_t)HALF * K * 2;
    const size_t tstep = 2 * hstep;
    const unsigned ldsw = (unsigned)wid * 1024u;
    const int aoff = lds_byte(wr * 64 + fr, fq * 8), boff = lds_byte(wc * 32 + fr, fq * 8);
#define PG8_SA(b, h) (((b) * 2 + (h)) * HTB)
#define PG8_SB(b, h) ((4 + (b) * 2 + (h)) * HTB)
#define PG8_STAGE(bufoff, gbase, voff) do { _Pragma("unroll") for (int _i = 0; _i < 2; ++_i) \
        __builtin_amdgcn_global_load_lds((const unsigned*)((const char*)(gbase) + (voff)[_i]), (LAS unsigned*)(lds + (bufoff) + ldsw + _i * 8192), 16, 0, 0); } while (0)
#define PG8_LDA(dst, b, h) do { _Pragma("unroll") for (int m = 0; m < 4; ++m) _Pragma("unroll") for (int k = 0; k < 2; ++k) dst[m][k] = *(const LAS bf16x8*)(lds + PG8_SA(b, h) + aoff + m * 2048 + k * 1024); } while (0)
#define PG8_LDB(dst, b, h) do { _Pragma("unroll") for (int n = 0; n < 2; ++n) _Pragma("unroll") for (int k = 0; k < 2; ++k) dst[n][k] = *(const LAS bf16x8*)(lds + PG8_SB(b, h) + boff + n * 2048 + k * 1024); } while (0)
#define PG8_MMA(ai, bj, At, Bt) do { __builtin_amdgcn_s_setprio(1); _Pragma("unroll") for (int m = 0; m < 4; ++m) _Pragma("unroll") for (int n = 0; n < 2; ++n) _Pragma("unroll") for (int k = 0; k < 2; ++k) \
        acc[ai][bj][m][n] = __builtin_amdgcn_mfma_f32_16x16x32_bf16(Bt[n][k], At[m][k], acc[ai][bj][m][n], 0, 0, 0); __builtin_amdgcn_s_setprio(0); } while (0)
#define PG8_WAIT_V(n) asm volatile("s_waitcnt vmcnt(" #n ")" ::: "memory")
#define PG8_WAIT_L(n) asm volatile("s_waitcnt lgkmcnt(" #n ")" ::: "memory")
#define PG8_BAR __builtin_amdgcn_s_barrier()
#define PG8_SCHED __builtin_amdgcn_sched_barrier(0)
    Unit cur, nxt; int ui = 0;
    if (!S.next(0, cur)) return;
    f32x4 acc[2][2][4][2];
#pragma unroll
    for (int a = 0; a < 2; ++a)
#pragma unroll
        for (int b = 0; b < 2; ++b)
#pragma unroll
            for (int m = 0; m < 4; ++m)
#pragma unroll
                for (int n = 0; n < 2; ++n) acc[a][b][m][n] = (f32x4){0.f, 0.f, 0.f, 0.f};
    bf16x8 At[4][2], B0[2][2], B1[2][2];
    const char* cA = (const char*)g.A + (size_t)cur.pm * tstep; const char* cB = (const char*)g.Bt + (size_t)cur.pn * tstep;
    PG8_STAGE(PG8_SB(0, 0), cB, voffA); PG8_STAGE(PG8_SB(0, 1), cB + hstep, voffA); PG8_STAGE(PG8_SA(0, 0), cA, voffA); PG8_STAGE(PG8_SA(0, 1), cA + hstep, voffA);
    if (wr == 1) PG8_BAR;
    PG8_WAIT_V(2); PG8_BAR;
    PG8_STAGE(PG8_SB(1, 0), cB + kstep, voffA); PG8_STAGE(PG8_SA(1, 0), cA + kstep, voffA); PG8_STAGE(PG8_SB(1, 1), cB + hstep + kstep, voffA);
    PG8_WAIT_V(6); PG8_BAR;
    for (;;) {
        const bool has_next = S.next(ui + 1, nxt);
        const char* nA = has_next ? (const char*)g.A + (size_t)nxt.pm * tstep : cA; const char* nB = has_next ? (const char*)g.Bt + (size_t)nxt.pn * tstep : cB;
        for (int t = 0; t < nt; t += 2) {
            const bool last = (t == nt - 2);
            const char* a1 = cA + (size_t)(t + 1) * kstep;
            const char* a2 = last ? nA : cA + (size_t)(t + 2) * kstep; const char* b2 = last ? nB : cB + (size_t)(t + 2) * kstep;
            const char* a3 = a2 + kstep; const char* b3 = b2 + kstep;
            PG8_LDB(B0, 0, 0); PG8_LDB(B1, 0, 1); PG8_SCHED; PG8_LDA(At, 0, 0); PG8_STAGE(PG8_SA(1, 1), a1 + hstep, voffA);
            PG8_WAIT_V(8); PG8_WAIT_L(0); PG8_BAR; PG8_MMA(0, 0, At, B0); PG8_MMA(0, 1, At, B1); PG8_BAR; PG8_SCHED;
            PG8_LDA(At, 0, 1); PG8_STAGE(PG8_SB(0, 0), b2, voffA); PG8_STAGE(PG8_SB(0, 1), b2 + hstep, voffA); PG8_STAGE(PG8_SA(0, 0), a2, voffA);
            PG8_WAIT_V(8); PG8_WAIT_L(0); PG8_BAR; PG8_MMA(1, 0, At, B0); PG8_MMA(1, 1, At, B1); PG8_BAR; PG8_SCHED;
            PG8_LDB(B0, 1, 0); PG8_LDB(B1, 1, 1); PG8_SCHED; PG8_LDA(At, 1, 0); PG8_STAGE(PG8_SA(0, 1), a2 + hstep, voffA);
            PG8_WAIT_V(8); PG8_WAIT_L(0); PG8_BAR; PG8_MMA(0, 0, At, B0); PG8_MMA(0, 1, At, B1); PG8_BAR; PG8_SCHED;
            PG8_LDA(At, 1, 1); PG8_STAGE(PG8_SB(1, 0), b3, voffA); PG8_STAGE(PG8_SB(1, 1), b3 + hstep, voffA); PG8_STAGE(PG8_SA(1, 0), a3, voffA);
            PG8_WAIT_V(8); PG8_WAIT_L(0); PG8_BAR; PG8_MMA(1, 0, At, B0); PG8_MMA(1, 1, At, B1); PG8_BAR; PG8_SCHED;
        }
        if (wr == 0) PG8_BAR;
        E(acc, cur, wr, wc, fr, fq);
        if (!has_next) break;
#pragma unroll
        for (int a = 0; a < 2; ++a)
#pragma unroll
            for (int b = 0; b < 2; ++b)
#pragma unroll
                for (int m = 0; m < 4; ++m)
#pragma unroll
                    for (int n = 0; n < 2; ++n) acc[a][b][m][n] = (f32x4){0.f, 0.f, 0.f, 0.f};
        cur = nxt; cA = nA; cB = nB; ++ui;
        if (wr == 1) PG8_BAR;
    }
    PG8_WAIT_V(0);
    PG8_BAR;
#undef PG8_SA
#undef PG8_SB
#undef PG8_STAGE
#undef PG8_LDA
#undef PG8_LDB
#undef PG8_MMA
#undef PG8_WAIT_V
#undef PG8_WAIT_L
#undef PG8_BAR
#undef PG8_SCHED
}
}

__device__ __forceinline__ float row_rscale(const float* __restrict__ rs, int row, int fq) {
    const float* p = rs + (size_t)(4 * fq) * MT + row;
    float s = (p[0] + p[MT]) + (p[2 * (size_t)MT] + p[3 * (size_t)MT]);
    s += __shfl_xor(s, 16); s += __shfl_xor(s, 32);
    return rsqrtf(s * (1.0f / DM) + EPSV);
}
__device__ __forceinline__ void row_rscale8(const float* __restrict__ rs, int row0, int fq, float (&r)[2][4]) {
    float s[2][4];
#pragma unroll
    for (int ai = 0; ai < 2; ++ai)
#pragma unroll
        for (int m = 0; m < 4; ++m) { const float* p = rs + (size_t)(4 * fq) * MT + row0 + ai * 128 + m * 16; s[ai][m] = (p[0] + p[MT]) + (p[2 * (size_t)MT] + p[3 * (size_t)MT]); }
#pragma unroll
    for (int ai = 0; ai < 2; ++ai)
#pragma unroll
        for (int m = 0; m < 4; ++m) { float t = s[ai][m]; t += __shfl_xor(t, 16); t += __shfl_xor(t, 32); r[ai][m] = rsqrtf(t * (1.0f / DM) + EPSV); }
}

__device__ __forceinline__ void store_pair16(bf16_t* xp, bf16_t* yp, u32x2 x, u32x2 y, int fq) {
    const u32x2 r0 = __builtin_amdgcn_permlane16_swap(x.x, y.x, false, false);
    const u32x2 r1 = __builtin_amdgcn_permlane16_swap(x.y, y.y, false, false);
    u32x4 d; d.x = r0.x; d.y = r1.x; d.z = r0.y; d.w = r1.y;
    bf16_t* p = (fq & 1) ? (yp - 4) : xp;
    *(u32x4*)p = d;
}

struct RCtx { const LAS float* rl; int pmA, pmB; };
__device__ __forceinline__ RCtx fill_row_scales(LAS unsigned char* lds, const pg8::StaticOrder& S, const float* __restrict__ rs, int row_base) {
    RCtx rc; rc.rl = (const LAS float*)(lds + pg8::STAGE_BYTES + 16); rc.pmA = 0; rc.pmB = 0;
    pg8::Unit u0, ul;
    if (S.next(0, u0)) {
        const int nun = (int)(((long)S.nwg - S.c + S.G - 1) / S.G); S.next(nun - 1, ul);
        rc.pmA = u0.pm; rc.pmB = ul.pm;
        const int tid = threadIdx.x, pm = (tid >> 8) ? ul.pm : u0.pm;
        const float* p = rs + (size_t)(row_base + pm * 256 + (tid & 255));
        float s0 = 0.f, s1 = 0.f, s2 = 0.f, s3 = 0.f;
#pragma unroll
        for (int k = 0; k < 4; ++k) { s0 += p[(size_t)(4 * k) * MT]; s1 += p[(size_t)(4 * k + 1) * MT]; s2 += p[(size_t)(4 * k + 2) * MT]; s3 += p[(size_t)(4 * k + 3) * MT]; }
        ((LAS float*)(lds + pg8::STAGE_BYTES + 16))[tid] = rsqrtf(((s0 + s1) + (s2 + s3)) * (1.0f / DM) + EPSV);
    }
    __syncthreads();
    return rc;
}
__device__ __forceinline__ void row_rscale8c(const RCtx& rc, const float* __restrict__ rs, int grow0, int pm, int lr0, int fq, float (&r)[2][4]) {
    if (pm == rc.pmA || pm == rc.pmB) {
        const LAS float* p = rc.rl + ((pm == rc.pmA) ? 0 : 256) + lr0;
#pragma unroll
        for (int ai = 0; ai < 2; ++ai)
#pragma unroll
            for (int m = 0; m < 4; ++m) r[ai][m] = p[ai * 128 + m * 16];
    } else row_rscale8(rs, grow0, fq, r);
}

struct EpiConv1 {
    const float* rs; bf16_t* Y; bf16_t* VE; bf16_t* GE; const float* ck; RCtx rc; bf16_t* Yhi;
    __device__ __forceinline__ void operator()(const f32x4 (&acc)[2][2][4][2], const pg8::Unit& u, int wr, int wc, int fr, int fq) const {
        const int e0 = u.pn * 64 + wc * 16 + fq * 4;
        float rsc[2][4]; row_rscale8c(rc, rs, u.pm * 256 + wr * 64 + fr, u.pm, wr * 64 + fr, fq, rsc);
        const f32x4 k0 = *(const f32x4*)(ck + e0), k1 = *(const f32x4*)(ck + EI + e0), k2 = *(const f32x4*)(ck + 2 * EI + e0);
#pragma unroll
        for (int ai = 0; ai < 2; ++ai) {
            float v[4][4], gg[4][4];
#pragma unroll
            for (int m = 0; m < 4; ++m) {
                const float r = rsc[ai][m];
                const f32x4 b = acc[ai][0][m][0] * r, c = acc[ai][0][m][1] * r, uu = acc[ai][1][m][0] * r, z = acc[ai][1][m][1] * r;
#pragma unroll
                for (int j = 0; j < 4; ++j) { v[m][j] = c[j] * uu[j]; gg[m][j] = b[j] * z[j] * fast_rcp(1.0f + fast_exp(-z[j])); }
            }
            const int blk = u.pm * 4 + ai * 2 + wr;
#pragma unroll
            for (int m = 0; m < 4; ++m) {
                const int row = u.pm * 256 + ai * 128 + wr * 64 + m * 16 + fr;
                float y[4];
#pragma unroll
                for (int j = 0; j < 4; ++j) {
                    const float pown = dppf<0x121>(v[m][j]);
                    const float pup = (m > 0) ? dppf<0x121>(v[m > 0 ? m - 1 : 0][j]) : 0.f;
                    const float nown = dppf<0x12f>(v[m][j]);
                    const float ndn = (m < 3) ? dppf<0x12f>(v[m < 3 ? m + 1 : 3][j]) : 0.f;
                    const float prev = (fr > 0) ? pown : pup, next = (fr < 15) ? nown : ndn;
                    y[j] = gg[m][j] * (k0[j] * prev + k1[j] * v[m][j] + k2[j] * next);
                }
                u32x2 wy; wy.x = cvt_pk_bf16(y[0], y[1]); wy.y = cvt_pk_bf16(y[2], y[3]);
                *(u32x2*)(((u.pm >= MH / 256) ? Yhi : Y) + (size_t)row * EI + e0) = wy;
                if (m == 0 || m == 3) {
                    u32x2 wv, wg; wv.x = cvt_pk_bf16(v[m][0], v[m][1]); wv.y = cvt_pk_bf16(v[m][2], v[m][3]); wg.x = cvt_pk_bf16(gg[m][0], gg[m][1]); wg.y = cvt_pk_bf16(gg[m][2], gg[m][3]);
                    if (m == 0 && fr < 2) *(u32x2*)(VE + ((size_t)blk * 4 + 2 + fr) * EI + e0) = wv;
                    if (m == 3 && fr >= 14) *(u32x2*)(VE + ((size_t)blk * 4 + (fr - 14)) * EI + e0) = wv;
                    if (m == 0 && fr == 0) *(u32x2*)(GE + ((size_t)blk * 2 + 1) * EI + e0) = wg;
                    if (m == 3 && fr == 15) *(u32x2*)(GE + ((size_t)blk * 2 + 0) * EI + e0) = wg;
                }
            }
        }
    }
};
struct EpiRes {
    bf16_t* xb; float* rs; int row_base;
    __device__ __forceinline__ void operator()(const f32x4 (&acc)[2][2][4][2], const pg8::Unit& u, int wr, int wc, int fr, int fq) const {
        bf16_t* base = xb + (size_t)(row_base + u.pm * 256 + wr * 64 + fr) * DM + u.pn * 256 + wc * 32 + fq * 4;
#pragma unroll
        for (int ai = 0; ai < 2; ++ai) {
            u32x2 xr[4][2][2];
#pragma unroll
            for (int m = 0; m < 4; ++m)
#pragma unroll
                for (int bj = 0; bj < 2; ++bj)
#pragma unroll
                    for (int n = 0; n < 2; ++n) xr[m][bj][n] = *(const u32x2*)(base + (size_t)(ai * 128 + m * 16) * DM + bj * 128 + n * 16);
#pragma unroll
            for (int m = 0; m < 4; ++m) {
                const int row = row_base + u.pm * 256 + ai * 128 + wr * 64 + m * 16 + fr;
                float ss = 0.f;
#pragma unroll
                for (int bj = 0; bj < 2; ++bj) {
                    u32x2 wn[2];
#pragma unroll
                    for (int n = 0; n < 2; ++n) {
                        const u32x2 xo = xr[m][bj][n]; const f32x4 a = acc[ai][bj][m][n];
                        const float x0 = bflo(xo.x) + a[0], x1 = bfhi(xo.x) + a[1], x2 = bflo(xo.y) + a[2], x3 = bfhi(xo.y) + a[3];
                        wn[n].x = cvt_pk_bf16(x0, x1); wn[n].y = cvt_pk_bf16(x2, x3);
                        ss += (x0 * x0 + x1 * x1) + (x2 * x2 + x3 * x3);
                    }
                    bf16_t* q = base + (size_t)(ai * 128 + m * 16) * DM + bj * 128;
                    store_pair16(q, q + 16, wn[0], wn[1], fq);
                }
                ss += __shfl_xor(ss, 16); ss += __shfl_xor(ss, 32);
                if (fq == 0) rs[(size_t)(u.pn * 4 + wc) * MT + row] = ss;
            }
        }
    }
};
struct EpiZ {
    const float* rs; bf16_t* ON; int row_base;
    __device__ __forceinline__ void operator()(const f32x4 (&acc)[2][2][4][2], const pg8::Unit& u, int wr, int wc, int fr, int fq) const {
        bf16_t* base = ON + (size_t)(u.pm * 256 + wr * 64 + fr) * EI + u.pn * 256 + wc * 32 + fq * 4;
        float rsc[2][4]; row_rscale8(rs, row_base + u.pm * 256 + wr * 64 + fr, fq, rsc);
#pragma unroll
        for (int ai = 0; ai < 2; ++ai) {
            u32x2 xr[4][2][2];
#pragma unroll
            for (int m = 0; m < 4; ++m)
#pragma unroll
                for (int bj = 0; bj < 2; ++bj)
#pragma unroll
                    for (int n = 0; n < 2; ++n) xr[m][bj][n] = *(const u32x2*)(base + (size_t)(ai * 128 + m * 16) * EI + bj * 128 + n * 16);
#pragma unroll
            for (int m = 0; m < 4; ++m) {
                const float r = rsc[ai][m];
#pragma unroll
                for (int bj = 0; bj < 2; ++bj)
#pragma unroll
                    for (int n = 0; n < 2; ++n) {
                        const u32x2 o = xr[m][bj][n]; const f32x4 z = acc[ai][bj][m][n] * r;
                        const float o0 = bflo(o.x), o1 = bfhi(o.x), o2 = bflo(o.y), o3 = bfhi(o.y);
                        const float y0 = o0 * z[0] * fast_rcp(1.0f + fast_exp(-z[0])), y1 = o1 * z[1] * fast_rcp(1.0f + fast_exp(-z[1]));
                        const float y2 = o2 * z[2] * fast_rcp(1.0f + fast_exp(-z[2])), y3 = o3 * z[3] * fast_rcp(1.0f + fast_exp(-z[3]));
                        u32x2 w; w.x = cvt_pk_bf16(y0, y1); w.y = cvt_pk_bf16(y2, y3);
                        *(u32x2*)(base + (size_t)(ai * 128 + m * 16) * EI + bj * 128 + n * 16) = w;
                    }
            }
        }
    }
};
__device__ __forceinline__ size_t hm_off(int lrow, int e) { return (size_t)(lrow >> 12) * ((size_t)EI * SEQ) + (size_t)(e >> 7) * ((size_t)SEQ * 128) + (size_t)(lrow & (SEQ - 1)) * 128 + (e & 127); }
struct EpiH1 {
    const float* rs; const float* lbl; int layer_j; int row_base;
    bf16_t *QEF, *KIF, *QEB, *KIB, *VV; float *DLF, *DLB; bf16_t* SZ; RCtx rc;
    __device__ __forceinline__ void operator()(const f32x4 (&acc)[2][2][4][2], const pg8::Unit& u, int wr, int wc, int fr, int fq) const {
        if (u.pn >= 32) {
            float rz[2][4]; row_rscale8c(rc, rs, row_base + u.pm * 256 + wr * 64 + fr, u.pm, wr * 64 + fr, fq, rz);
            bf16_t* base = SZ + (size_t)(u.pm * 256 + wr * 64 + fr) * EI + (u.pn - 32) * 256 + wc * 32 + fq * 4;
#pragma unroll
            for (int ai = 0; ai < 2; ++ai)
#pragma unroll
                for (int m = 0; m < 4; ++m)
#pragma unroll
                    for (int bj = 0; bj < 2; ++bj) {
                        u32x2 wn[2];
#pragma unroll
                        for (int n = 0; n < 2; ++n) {
                            const f32x4 z = acc[ai][bj][m][n] * rz[ai][m];
                            const float y0 = z[0] * fast_rcp(1.0f + fast_exp(-z[0])), y1 = z[1] * fast_rcp(1.0f + fast_exp(-z[1]));
                            const float y2 = z[2] * fast_rcp(1.0f + fast_exp(-z[2])), y3 = z[3] * fast_rcp(1.0f + fast_exp(-z[3]));
                            wn[n].x = cvt_pk_bf16(y0, y1); wn[n].y = cvt_pk_bf16(y2, y3);
                        }
                        bf16_t* q = base + (size_t)(ai * 128 + m * 16) * EI + bj * 128;
                        store_pair16(q, q + 16, wn[0], wn[1], fq);
                    }
            return;
        }
        const int e0 = u.pn * 64 + wc * 16 + fq * 4;
        float oml[4];
#pragma unroll
        for (int j = 0; j < 4; ++j) {
            float lb = 0.f;
            if (layer_j == 1) { const float l0 = lbl[e0 + j], l1 = lbl[EI + e0 + j], mx = fmaxf(l0, l1), a0 = __expf(l0 - mx), a1 = __expf(l1 - mx), sm = a0 + a1, p0 = a0 / sm, p1 = a1 / sm; lb = (p0 + p1) - p0; }
            lb = fminf(fmaxf(lb, 0.f), 1.0f - 1e-6f);
            oml[j] = 1.0f - lb;
        }
        const float qscale = 0.08838834764831845f;
        float rsc[2][4]; row_rscale8c(rc, rs, row_base + u.pm * 256 + wr * 64 + fr, u.pm, wr * 64 + fr, fq, rsc);
#pragma unroll
        for (int ai = 0; ai < 2; ++ai)
#pragma unroll
            for (int mm = 0; mm < 2; ++mm) {
                const int m0 = 2 * mm, m1 = 2 * mm + 1;
                const int lrow0 = u.pm * 256 + ai * 128 + wr * 64 + m0 * 16 + fr, lrow1 = lrow0 + 16;
                const float r0 = rsc[ai][m0], r1 = rsc[ai][m1], r0l = r0 * 1.44269504089f, r1l = r1 * 1.44269504089f;
                float qf0[4], qf1[4], kf0[4], kf1[4], qb0[4], qb1[4], kb0[4], kb1[4], dlf[4], dlb[4];
#pragma unroll
                for (int j = 0; j < 4; ++j) {
                    const float q0 = acc[ai][0][m0][0][j] * (r0 * qscale), q1 = acc[ai][0][m1][0][j] * (r1 * qscale);
                    {
                        const float k0 = oml[j] * fast_rcp(1.0f + fast_exp2(acc[ai][0][m0][1][j] * r0l)), k1 = oml[j] * fast_rcp(1.0f + fast_exp2(acc[ai][0][m1][1][j] * r1l));
                        const float e0_ = row_prefprod16(1.0f - k0); const float e1_ = row_prefprod16(1.0f - k1) * dppf<0x15f>(e0_);
                        const float E0 = fmaxf(e0_, 1e-30f), E1 = fmaxf(e1_, 1e-30f);
                        qf0[j] = q0 * E0; qf1[j] = q1 * E1; kf0[j] = k0 * fast_rcp(E0); kf1[j] = k1 * fast_rcp(E1);
                        dlf[j] = E1;
                    }
                    {
                        const float k0 = oml[j] * fast_rcp(1.0f + fast_exp2(acc[ai][1][m0][0][j] * r0l)), k1 = oml[j] * fast_rcp(1.0f + fast_exp2(acc[ai][1][m1][0][j] * r1l));
                        const float e1_ = row_sufprod16(1.0f - k1); const float e0_ = row_sufprod16(1.0f - k0) * dppf<0x150>(e1_);
                        const float E0 = fmaxf(e0_, 1e-30f), E1 = fmaxf(e1_, 1e-30f);
                        qb0[j] = q0 * E0; qb1[j] = q1 * E1; kb0[j] = k0 * fast_rcp(E0); kb1[j] = k1 * fast_rcp(E1);
                        dlb[j] = E0;
                    }
                }
                const size_t o0 = hm_off(lrow0, e0), o1 = o0 + 16 * 128;
                u32x2 wa, wb;
                wa.x = cvt_pk_bf16(qf0[0], qf0[1]); wa.y = cvt_pk_bf16(qf0[2], qf0[3]); wb.x = cvt_pk_bf16(kf0[0], kf0[1]); wb.y = cvt_pk_bf16(kf0[2], kf0[3]); store_pair16(QEF + o0, KIF + o0, wa, wb, fq);
                wa.x = cvt_pk_bf16(qf1[0], qf1[1]); wa.y = cvt_pk_bf16(qf1[2], qf1[3]); wb.x = cvt_pk_bf16(kf1[0], kf1[1]); wb.y = cvt_pk_bf16(kf1[2], kf1[3]); store_pair16(QEF + o1, KIF + o1, wa, wb, fq);
                wa.x = cvt_pk_bf16(qb0[0], qb0[1]); wa.y = cvt_pk_bf16(qb0[2], qb0[3]); wb.x = cvt_pk_bf16(kb0[0], kb0[1]); wb.y = cvt_pk_bf16(kb0[2], kb0[3]); store_pair16(QEB + o0, KIB + o0, wa, wb, fq);
                wa.x = cvt_pk_bf16(qb1[0], qb1[1]); wa.y = cvt_pk_bf16(qb1[2], qb1[3]); wb.x = cvt_pk_bf16(kb1[0], kb1[1]); wb.y = cvt_pk_bf16(kb1[2], kb1[3]); store_pair16(QEB + o1, KIB + o1, wa, wb, fq);
                const f32x4 i0 = acc[ai][1][m0][1] * r0, i1 = acc[ai][1][m1][1] * r1;
                wa.x = cvt_pk_bf16(i0[0], i0[1]); wa.y = cvt_pk_bf16(i0[2], i0[3]); wb.x = cvt_pk_bf16(i1[0], i1[1]); wb.y = cvt_pk_bf16(i1[2], i1[3]); store_pair16(VV + o0, VV + o1, wa, wb, fq);
                const size_t oc = (size_t)(lrow0 >> 5) * EI + e0;
                if (fr == 15) *(f32x4*)(DLF + oc) = (f32x4){dlf[0], dlf[1], dlf[2], dlf[3]};
                if (fr == 0) *(f32x4*)(DLB + oc) = (f32x4){dlb[0], dlb[1], dlb[2], dlb[3]};
            }
    }
};

struct EpiSZ {
    const float* rs; int row_base; bf16_t* SZ; RCtx rc;
    __device__ __forceinline__ void operator()(const f32x4 (&acc)[2][2][4][2], const pg8::Unit& u, int wr, int wc, int fr, int fq) const {
            float rz[2][4]; row_rscale8c(rc, rs, row_base + u.pm * 256 + wr * 64 + fr, u.pm, wr * 64 + fr, fq, rz);
            bf16_t* base = SZ + (size_t)(u.pm * 256 + wr * 64 + fr) * EI + u.pn * 256 + wc * 32 + fq * 4;
#pragma unroll
            for (int ai = 0; ai < 2; ++ai)
#pragma unroll
                for (int m = 0; m < 4; ++m)
#pragma unroll
                    for (int bj = 0; bj < 2; ++bj) {
                        u32x2 wn[2];
#pragma unroll
                        for (int n = 0; n < 2; ++n) {
                            const f32x4 z = acc[ai][bj][m][n] * rz[ai][m];
                            const float y0 = z[0] * fast_rcp(1.0f + fast_exp(-z[0])), y1 = z[1] * fast_rcp(1.0f + fast_exp(-z[1]));
                            const float y2 = z[2] * fast_rcp(1.0f + fast_exp(-z[2])), y3 = z[3] * fast_rcp(1.0f + fast_exp(-z[3]));
                            wn[n].x = cvt_pk_bf16(y0, y1); wn[n].y = cvt_pk_bf16(y2, y3);
                        }
                        bf16_t* q = base + (size_t)(ai * 128 + m * 16) * EI + bj * 128;
                        store_pair16(q, q + 16, wn[0], wn[1], fq);
                    }
    }
};

__device__ __forceinline__ int perm_col(int col) {
    const int type = col >> 11, e = col & 2047;
    return (e >> 6) * 256 + (type >> 1) * 128 + ((e >> 4) & 3) * 32 + (type & 1) * 16 + ((e >> 2) & 3) * 4 + (e & 3);
}
struct TileDesc { const float* src; const float* nw; bf16_t* dst; int ld_src, ld_dst, k0, c0, perm_limit; };
struct Params {
    const float* x; const float* norm_w; const float* final_norm_w; const float* conv_w_in; const float* conv_kernel; const float* conv_w_out;
    const float* hgrn_w_in; const float* hgrn_lb; const float* hgrn_norm_w; const float* hgrn_w_out;
    float* out; unsigned char* ws; int never; int pad;
};
__device__ __forceinline__ TileDesc tile_desc(const Params& P, int t) {
    TileDesc d;
    if (t < 4096) { const int l = t >> 11, r = t & 2047, kt = r >> 7, ct = r & 127;
        d.src = P.conv_w_in + (size_t)l * DM * 8192; d.ld_src = 8192; d.k0 = kt * 64; d.c0 = ct * 64; d.nw = P.norm_w + (size_t)(2 * l) * DM; d.dst = (bf16_t*)(P.ws + WS_WCIN) + (size_t)l * 8192 * DM; d.ld_dst = DM; d.perm_limit = 8192;
    } else if (t < 4096 + 5120) { const int q = t - 4096, l = q / 2560, r = q % 2560, kt = r / 160, ct = r % 160;
        d.src = P.hgrn_w_in + (size_t)l * DM * 10240; d.ld_src = 10240; d.k0 = kt * 64; d.c0 = ct * 64; d.nw = P.norm_w + (size_t)(2 * l + 1) * DM; d.dst = (bf16_t*)(P.ws + WS_WHIN) + (size_t)l * 10240 * DM; d.ld_dst = DM; d.perm_limit = 8192;
    } else if (t < 4096 + 5120 + 1024) { const int q = t - 9216, l = q >> 9, r = q & 511, kt = r >> 4, ct = r & 15;
        d.src = P.conv_w_out + (size_t)l * EI * DM; d.ld_src = DM; d.k0 = kt * 64; d.c0 = ct * 64; d.nw = nullptr; d.dst = (bf16_t*)(P.ws + WS_WCOUT) + (size_t)l * DM * EI; d.ld_dst = EI; d.perm_limit = 0;
    } else { const int q = t - 10240, l = q >> 9, r = q & 511, kt = r >> 4, ct = r & 15;
        d.src = P.hgrn_w_out + (size_t)l * EI * DM; d.ld_src = DM; d.k0 = kt * 64; d.c0 = ct * 64; d.nw = nullptr; d.dst = (bf16_t*)(P.ws + WS_WHOUT) + (size_t)l * DM * EI; d.ld_dst = EI; d.perm_limit = 0;
    }
    return d;
}

__device__ __forceinline__ void prologue(const Params& P, LAS unsigned char* lds) {
    LAS float* tiles = (LAS float*)lds;
    const int G = gridDim.x, bid = blockIdx.x, tid = threadIdx.x;
    constexpr int NT = 4096 + 5120 + 1024 + 1024, NG = NT / 4;
    for (int grp = bid; grp < NG; grp += G) {
        f32x4 v[4][2];
        const int rr = tid >> 4, cc = (tid & 15) * 4;
#pragma unroll
        for (int q = 0; q < 4; ++q) { const TileDesc d = tile_desc(P, grp * 4 + q);
#pragma unroll
            for (int p = 0; p < 2; ++p) v[q][p] = *(const f32x4*)(d.src + (size_t)(d.k0 + rr + 32 * p) * d.ld_src + d.c0 + cc); }
#pragma unroll
        for (int q = 0; q < 4; ++q)
#pragma unroll
            for (int p = 0; p < 2; ++p) { LAS float* t = tiles + q * (64 * 65) + (rr + 32 * p) * 65 + cc; t[0] = v[q][p][0]; t[1] = v[q][p][1]; t[2] = v[q][p][2]; t[3] = v[q][p][3]; }
        __syncthreads();
        const int c = tid >> 3, ks = (tid & 7) * 8;
#pragma unroll
        for (int q = 0; q < 4; ++q) { const TileDesc d = tile_desc(P, grp * 4 + q);
            float w8[8];
#pragma unroll
            for (int i = 0; i < 8; ++i) { w8[i] = tiles[q * (64 * 65) + (ks + i) * 65 + c]; if (d.nw) w8[i] *= d.nw[d.k0 + ks + i]; }
            const int col = d.c0 + c, drow = (col < d.perm_limit) ? perm_col(col) : col;
            u32x4 w; w.x = cvt_pk_bf16(w8[0], w8[1]); w.y = cvt_pk_bf16(w8[2], w8[3]); w.z = cvt_pk_bf16(w8[4], w8[5]); w.w = cvt_pk_bf16(w8[6], w8[7]);
            *(u32x4*)(d.dst + (size_t)drow * d.ld_dst + d.k0 + ks) = w; }
        __syncthreads();
    }
    const int lane = tid & 63, gw = bid * 8 + (tid >> 6), nw_ = G * 8;
    bf16_t* xb = (bf16_t*)(P.ws + WS_XB); float* rs = (float*)(P.ws + WS_RS);
    for (int row = gw; row < MT; row += 2 * nw_) {
        f32x4 v[2][4];
#pragma unroll
        for (int q = 0; q < 2; ++q)
#pragma unroll
            for (int i = 0; i < 4; ++i) v[q][i] = *(const f32x4*)(P.x + (size_t)(row + q * nw_) * DM + i * 256 + lane * 4);
#pragma unroll
        for (int q = 0; q < 2; ++q) {
            float ss = 0.f;
#pragma unroll
            for (int i = 0; i < 4; ++i) {
                const f32x4 a = v[q][i];
                ss += (a[0] * a[0] + a[1] * a[1]) + (a[2] * a[2] + a[3] * a[3]);
                u32x2 w; w.x = cvt_pk_bf16(a[0], a[1]); w.y = cvt_pk_bf16(a[2], a[3]); *(u32x2*)(xb + (size_t)(row + q * nw_) * DM + i * 256 + lane * 4) = w;
            }
#pragma unroll
            for (int o = 32; o >= 1; o >>= 1) ss += __shfl_xor(ss, o);
            if (lane < 16) rs[(size_t)lane * MT + row + q * nw_] = lane == 0 ? ss : 0.f;
        }
    }
}

__device__ __forceinline__ void conv_fix(bf16_t* Y, bf16_t* Yhi, const bf16_t* __restrict__ VE, const bf16_t* __restrict__ GE, const float* __restrict__ ck  ) {
    const int nthreads = gridDim.x * 512; constexpr int NBLK = MT / 64;
    for (int task = blockIdx.x * 512 + threadIdx.x; task < (NBLK + 1) * 256; task += nthreads) {
        const int ec = task & 255, B = task >> 8, e0 = ec * 8, t = 64 * B;
        const bool seqb = (t & (SEQ - 1)) == 0, hasp = B > 0, hasn = B < NBLK;
        const u32x4 zero = (u32x4){0u, 0u, 0u, 0u};
        u32x4 va = zero, vb = zero, gb = zero, vc = zero, vd = zero, gc = zero;
        if (hasp) { va = *(const u32x4*)(VE + ((size_t)(B - 1) * 4 + 0) * EI + e0); vb = *(const u32x4*)(VE + ((size_t)(B - 1) * 4 + 1) * EI + e0); gb = *(const u32x4*)(GE + ((size_t)(B - 1) * 2 + 0) * EI + e0); }
        if (hasn) { vc = *(const u32x4*)(VE + ((size_t)B * 4 + 2) * EI + e0); vd = *(const u32x4*)(VE + ((size_t)B * 4 + 3) * EI + e0); gc = *(const u32x4*)(GE + ((size_t)B * 2 + 1) * EI + e0); }
        float k0[8], k1[8], k2[8];
#pragma unroll
        for (int i = 0; i < 8; ++i) { k0[i] = ck[e0 + i]; k1[i] = ck[EI + e0 + i]; k2[i] = ck[2 * EI + e0 + i]; }
        const u32x4 vcn = seqb ? zero : vc, vbp = seqb ? zero : vb;
        float y1[8], y2[8];
#pragma unroll
        for (int h = 0; h < 4; ++h) {
            y1[2 * h] = bflo(gb[h]) * (k0[2 * h] * bflo(va[h]) + k1[2 * h] * bflo(vb[h]) + k2[2 * h] * bflo(vcn[h]));
            y1[2 * h + 1] = bfhi(gb[h]) * (k0[2 * h + 1] * bfhi(va[h]) + k1[2 * h + 1] * bfhi(vb[h]) + k2[2 * h + 1] * bfhi(vcn[h]));
            y2[2 * h] = bflo(gc[h]) * (k0[2 * h] * bflo(vbp[h]) + k1[2 * h] * bflo(vc[h]) + k2[2 * h] * bflo(vd[h]));
            y2[2 * h + 1] = bfhi(gc[h]) * (k0[2 * h + 1] * bfhi(vbp[h]) + k1[2 * h + 1] * bfhi(vc[h]) + k2[2 * h + 1] * bfhi(vd[h]));
        }
        if (hasp) { u32x4 w; w.x = cvt_pk_bf16(y1[0], y1[1]); w.y = cvt_pk_bf16(y1[2], y1[3]); w.z = cvt_pk_bf16(y1[4], y1[5]); w.w = cvt_pk_bf16(y1[6], y1[7]); *(u32x4*)(((t - 1 >= MH) ? Yhi : Y) + (size_t)(t - 1) * EI + e0) = w; }
        if (hasn) { u32x4 w; w.x = cvt_pk_bf16(y2[0], y2[1]); w.y = cvt_pk_bf16(y2[2], y2[3]); w.z = cvt_pk_bf16(y2[4], y2[5]); w.w = cvt_pk_bf16(y2[6], y2[7]); *(u32x4*)(((t >= MH) ? Yhi : Y) + (size_t)t * EI + e0) = w; }
    }
}

__device__ __forceinline__ unsigned offb(unsigned row, unsigned ch) { return 256u * row + 16u * (ch ^ (((row & 3u) << 2) | ((row >> 2) & 3u))); }
constexpr int SCAN_BUF = 8192 + 8192 + 8192 + 512;
constexpr int SCAN_XCH = 2 * SCAN_BUF;
__device__ __forceinline__ bf16x8 pack8(const f32x4 a, const f32x4 b) {
    u32x4 w; w.x = cvt_pk_bf16(a[0], a[1]); w.y = cvt_pk_bf16(a[2], a[3]); w.z = cvt_pk_bf16(b[0], b[1]); w.w = cvt_pk_bf16(b[2], b[3]);
    return __builtin_bit_cast(bf16x8, w);
}
__device__ __forceinline__ bf16x8 join8(u32x2 lo, u32x2 hi) { u32x4 w; w.x = lo.x; w.y = lo.y; w.z = hi.x; w.w = hi.y; return __builtin_bit_cast(bf16x8, w); }

__device__ __forceinline__ void scan_phase(LAS unsigned char* lds, bf16_t* QEF, const bf16_t* __restrict__ KIF, bf16_t* QEB, const bf16_t* __restrict__ KIB,
                                           const bf16_t* __restrict__ VV, const float* __restrict__ DLF, const float* __restrict__ DLB) {
    int tid = threadIdx.x; asm volatile("" : "+v"(tid));
    const int lane = tid & 63, w = __builtin_amdgcn_readfirstlane(tid >> 6), c = lane & 15, g = lane >> 4, kh = w >> 2, vq = w & 3;
    const unsigned lbase = (unsigned)(unsigned long long)lds;
    for (int item = blockIdx.x; item < 128; item += gridDim.x) {
        const int dir = item & 1, h = (item >> 1) & 15, b = item >> 5;
        bf16_t* QE = dir ? QEB : QEF; const bf16_t* KI = dir ? KIB : KIF; const float* DL = dir ? DLB : DLF;
        const int lrow = tid >> 4, lch = tid & 15;
        const size_t hbase = (size_t)b * ((size_t)EI * SEQ) + (size_t)h * ((size_t)SEQ * 128);
        const bf16_t* qk_src = ((lch < 8) ? (const bf16_t*)QE : KI) + hbase + (size_t)lrow * 128 + (lch & 7) * 8;
        const bf16_t* v_src = VV + hbase + (size_t)lrow * 128 + lch * 8;
        const float* dl_src = DL + (size_t)(b * (SEQ / 32)) * EI + h * 128 + (tid & 127);
        const unsigned st_qk = offb(lrow, lch), st_v = 16384u + offb(lrow, lch);
        const unsigned rq = (unsigned)(g >> 1);
        const unsigned rrow = (unsigned)c;
        const unsigned swz = ((rrow & 3u) << 2) | ((rrow >> 2) & 3u);
        const unsigned rowb = (unsigned)kh * 8192u + 256u * rrow + (unsigned)(g & 1) * 8u;
        const unsigned trow = 4u * (unsigned)g + ((unsigned)c >> 2), tp = (unsigned)c & 3u;
        const unsigned tr_v0 = 16384u + offb(trow, 2u * (unsigned)(2 * vq) + (tp >> 1)) + 8u * (tp & 1u);
        const unsigned tr_v1 = 16384u + offb(trow, 2u * (unsigned)(2 * vq + 1) + (tp >> 1)) + 8u * (tp & 1u);
        unsigned tr_k[4];
#pragma unroll
        for (int kt = 0; kt < 4; ++kt) tr_k[kt] = (unsigned)kh * 8192u + offb(trow, 2u * (unsigned)(4 + kt) + (tp >> 1)) + 8u * (tp & 1u);
        bf16_t* o_dst = QE + hbase + (size_t)c * 128 + vq * 32 + g * 4;
        const unsigned xchw = (unsigned)SCAN_XCH + (unsigned)kh * 16384u + (unsigned)vq * 4096u + (unsigned)lane * 16u;
        const unsigned xchr = (unsigned)SCAN_XCH + (unsigned)vq * 4096u + (unsigned)(kh * 2) * 1024u + (unsigned)lane * 16u;
        const unsigned dlo = 24576u + (unsigned)(kh * 64 + 4 * g) * 4u;

        f32x4 S[2][4];
#pragma unroll
        for (int vt = 0; vt < 2; ++vt) {
#pragma unroll
            for (int kt = 0; kt < 4; ++kt) S[vt][kt] = (f32x4){0.f, 0.f, 0.f, 0.f};
        }
#define SCAN_CI(s_) (dir ? 127 - ((s_) < 127 ? (s_) : 127) : ((s_) < 127 ? (s_) : 127))
#define SCAN_LOAD(cn_, P0, P1, PV, PD) do { P0 = __builtin_nontemporal_load((const u32x4*)(qk_src + (size_t)(cn_) * 32 * 128)); P1 = __builtin_nontemporal_load((const u32x4*)(qk_src + (size_t)(cn_) * 32 * 128 + 64)); \
            PV = __builtin_nontemporal_load((const u32x4*)(v_src + (size_t)(cn_) * 32 * 128)); if (tid < 128) PD = dl_src[(size_t)(cn_) * EI]; } while (0)
#define SCAN_PUT(bn_, P0, P1, PV, PD) do { *(LAS u32x4*)(lds + (bn_) + st_qk) = P0; *(LAS u32x4*)(lds + (bn_) + 8192u + st_qk) = P1; \
            *(LAS u32x4*)(lds + (bn_) + st_v) = PV; if (tid < 128) *(LAS float*)(lds + (bn_) + 24576u + tid * 4) = PD; } while (0)
        const u32x4 z4 = (u32x4){0u, 0u, 0u, 0u};
        u32x4 p0A = z4, p1A = z4, pvA = z4, p0B = z4, p1B = z4, pvB = z4, p0C = z4, p1C = z4, pvC = z4, p0D = z4, p1D = z4, pvD = z4; float pdA = 0.f, pdB = 0.f, pdC = 0.f, pdD = 0.f;
        {
            SCAN_LOAD(SCAN_CI(0), p0A, p1A, pvA, pdA); SCAN_LOAD(SCAN_CI(1), p0B, p1B, pvB, pdB); SCAN_LOAD(SCAN_CI(2), p0C, p1C, pvC, pdC); SCAN_LOAD(SCAN_CI(3), p0D, p1D, pvD, pdD);
            SCAN_PUT(0u, p0A, p1A, pvA, pdA);
        }
        __syncthreads();
#define SCAN_FLUSH(s_) do { const int cp = SCAN_CI((s_) - 1); const unsigned xo = xchr + (unsigned)(((s_) - 1) & 1) * 32768u; u32x2 wv[2]; \
            _Pragma("unroll") for (int pt = 0; pt < 2; ++pt) { const f32x4 o = *(const LAS f32x4*)(lds + xo + pt * 1024) + *(const LAS f32x4*)(lds + xo + 16384u + pt * 1024); \
                wv[pt].x = cvt_pk_bf16(o[0], o[1]); wv[pt].y = cvt_pk_bf16(o[2], o[3]); } \
            store_pair16(o_dst + (size_t)(cp * 32) * 128 + kh * 16, o_dst + (size_t)(cp * 32 + 16) * 128 + kh * 16, wv[0], wv[1], g); } while (0)
#define SCAN_STEP(s_, BO, BN, P0W, P1W, PVW, PDW, P0L, P1L, PVL, PDL) do { \
            const unsigned bo = (BO), bn = (BN); \
            SCAN_LOAD(SCAN_CI((s_) + 4), P0L, P1L, PVL, PDL); \
            bf16x8 qeB[2][2], kiA[2][2]; \
            _Pragma("unroll") for (int kk = 0; kk < 2; ++kk) { \
                const unsigned ch0 = (unsigned)(4 * kk) | rq, ch1 = ch0 | 2u; \
                const unsigned a0 = bo + rowb + 16u * (ch0 ^ swz), a1 = bo + rowb + 16u * (ch1 ^ swz); \
                const unsigned k0 = bo + rowb + 16u * ((ch0 | 8u) ^ swz), k1 = bo + rowb + 16u * ((ch1 | 8u) ^ swz); \
                _Pragma("unroll") for (int pt = 0; pt < 2; ++pt) { \
                    qeB[pt][kk] = join8(*(const LAS u32x2*)(lds + a0 + pt * 4096), *(const LAS u32x2*)(lds + a1 + pt * 4096)); \
                    kiA[pt][kk] = join8(*(const LAS u32x2*)(lds + k0 + pt * 4096), *(const LAS u32x2*)(lds + k1 + pt * 4096)); } } \
            u32x2 vlo[2], vhi[2], klo[4], khi[4]; \
            { const unsigned av0 = lbase + bo + tr_v0, av1 = lbase + bo + tr_v1, ak0 = lbase + bo + tr_k[0], ak1 = lbase + bo + tr_k[1], ak2 = lbase + bo + tr_k[2], ak3 = lbase + bo + tr_k[3]; \
              asm volatile("ds_read_b64_tr_b16 %0, %12\n\tds_read_b64_tr_b16 %1, %12 offset:4096\n\t" \
                           "ds_read_b64_tr_b16 %2, %13\n\tds_read_b64_tr_b16 %3, %13 offset:4096\n\t" \
                           "ds_read_b64_tr_b16 %4, %14\n\tds_read_b64_tr_b16 %5, %14 offset:4096\n\t" \
                           "ds_read_b64_tr_b16 %6, %15\n\tds_read_b64_tr_b16 %7, %15 offset:4096\n\t" \
                           "ds_read_b64_tr_b16 %8, %16\n\tds_read_b64_tr_b16 %9, %16 offset:4096\n\t" \
                           "ds_read_b64_tr_b16 %10, %17\n\tds_read_b64_tr_b16 %11, %17 offset:4096\n\t" \
                           "s_waitcnt lgkmcnt(0)" \
                           : "=&v"(vlo[0]), "=&v"(vhi[0]), "=&v"(vlo[1]), "=&v"(vhi[1]), "=&v"(klo[0]), "=&v"(khi[0]), "=&v"(klo[1]), "=&v"(khi[1]), "=&v"(klo[2]), "=&v"(khi[2]), "=&v"(klo[3]), "=&v"(khi[3]) \
                           : "v"(av0), "v"(av1), "v"(ak0), "v"(ak1), "v"(ak2), "v"(ak3) : "memory"); } \
            bf16x8 ATp[2]; \
            { f32x4 AT[2][2]; \
              _Pragma("unroll") for (int ut = 0; ut < 2; ++ut) _Pragma("unroll") for (int pt = 0; pt < 2; ++pt) { \
                f32x4 z = (f32x4){0.f, 0.f, 0.f, 0.f}; \
                z = __builtin_amdgcn_mfma_f32_16x16x32_bf16(kiA[ut][0], qeB[pt][0], z, 0, 0, 0); \
                z = __builtin_amdgcn_mfma_f32_16x16x32_bf16(kiA[ut][1], qeB[pt][1], z, 0, 0, 0); \
                _Pragma("unroll") for (int i = 0; i < 4; ++i) { const int uu = 16 * ut + 4 * g + i, pp = 16 * pt + c; const bool keep = dir ? (uu >= pp) : (uu <= pp); z[i] = keep ? z[i] : 0.f; } \
                AT[ut][pt] = z; } \
              ATp[0] = pack8(AT[0][0], AT[1][0]); ATp[1] = pack8(AT[0][1], AT[1][1]); } \
            _Pragma("unroll") for (int vt = 0; vt < 2; ++vt) { \
                const bf16x8 vT = join8(vlo[vt], vhi[vt]); \
                const bf16x8 Sf0 = pack8(S[vt][0], S[vt][1]), Sf1 = pack8(S[vt][2], S[vt][3]); \
                _Pragma("unroll") for (int pt = 0; pt < 2; ++pt) { \
                    f32x4 o = (f32x4){0.f, 0.f, 0.f, 0.f}; \
                    o = __builtin_amdgcn_mfma_f32_16x16x32_bf16(Sf0, qeB[pt][0], o, 0, 0, 0); \
                    o = __builtin_amdgcn_mfma_f32_16x16x32_bf16(Sf1, qeB[pt][1], o, 0, 0, 0); \
                    o = __builtin_amdgcn_mfma_f32_16x16x32_bf16(vT, ATp[pt], o, 0, 0, 0); \
                    *(LAS f32x4*)(lds + xchw + (unsigned)((s_) & 1) * 32768u + (vt * 2 + pt) * 1024) = o; } \
                _Pragma("unroll") for (int kt = 0; kt < 4; ++kt) { \
                    S[vt][kt] = __builtin_amdgcn_mfma_f32_16x16x32_bf16(join8(klo[kt], khi[kt]), vT, S[vt][kt], 0, 0, 0); \
                    S[vt][kt] = S[vt][kt] * *(const LAS f32x4*)(lds + bo + dlo + 64 * kt); } } \
            if ((s_) > 0) SCAN_FLUSH(s_);     \
            SCAN_PUT(bn, P0W, P1W, PVW, PDW); \
            __syncthreads(); } while (0)
        for (int s = 0; s < 128; s += 4) {
            SCAN_STEP(s, 0u, (unsigned)SCAN_BUF, p0B, p1B, pvB, pdB, p0A, p1A, pvA, pdA);
            SCAN_STEP(s + 1, (unsigned)SCAN_BUF, 0u, p0C, p1C, pvC, pdC, p0B, p1B, pvB, pdB);
            SCAN_STEP(s + 2, 0u, (unsigned)SCAN_BUF, p0D, p1D, pvD, pdD, p0C, p1C, pvC, pdC);
            SCAN_STEP(s + 3, (unsigned)SCAN_BUF, 0u, p0A, p1A, pvA, pdA, p0D, p1D, pvD, pdD);
        }
        SCAN_FLUSH(128);
        __syncthreads();
#undef SCAN_STEP
#undef SCAN_FLUSH
#undef SCAN_PUT
#undef SCAN_LOAD
#undef SCAN_CI
    }
}

__device__ __forceinline__ void combine_phase(const bf16_t* __restrict__ OF, const bf16_t* __restrict__ OB, const bf16_t* __restrict__ SZ, bf16_t* __restrict__ ON, const float* __restrict__ nw) {
    const int nthreads = gridDim.x * 512;
    for (int task0 = blockIdx.x * 512 + threadIdx.x; task0 < MH * 256; task0 += 2 * nthreads) {
        u32x4 a0[2], b0[2], zz[2];
#pragma unroll
        for (int q = 0; q < 2; ++q) {
            const int task = task0 + q * nthreads; const int cv = task & 15, tin = (task >> 4) & (SEQ - 1), hh = (task >> 16) & 15, bb = task >> 20;
            const size_t off = (size_t)bb * ((size_t)EI * SEQ) + (size_t)hh * ((size_t)SEQ * 128) + (size_t)tin * 128 + cv * 8;
            a0[q] = *(const u32x4*)(OF + off); b0[q] = *(const u32x4*)(OB + off);
            zz[q] = *(const u32x4*)(SZ + (size_t)(bb * SEQ + tin) * EI + hh * 128 + cv * 8);
        }
#pragma unroll
        for (int q = 0; q < 2; ++q) {
            const int task = task0 + q * nthreads; const int cv = task & 15, tin = (task >> 4) & (SEQ - 1), hh = (task >> 16) & 15, bb = task >> 20, t = bb * SEQ + tin;
            float o[8]; float ss = 0.f;
#pragma unroll
            for (int i = 0; i < 4; ++i) {
                o[2 * i] = bflo(a0[q][i]) + bflo(b0[q][i]);
                o[2 * i + 1] = bfhi(a0[q][i]) + bfhi(b0[q][i]);
                ss += o[2 * i] * o[2 * i] + o[2 * i + 1] * o[2 * i + 1];
            }
            ss += __shfl_xor(ss, 1); ss += __shfl_xor(ss, 2); ss += __shfl_xor(ss, 4); ss += __shfl_xor(ss, 8);
            const float r = rsqrtf(ss * (1.0f / 128.0f) + EPSV);
            const int e = hh * 128 + cv * 8;
            const f32x4 w0 = *(const f32x4*)(nw + e), w1 = *(const f32x4*)(nw + e + 4);
            u32x4 w; w.x = cvt_pk_bf16(o[0] * r * w0[0] * bflo(zz[q].x), o[1] * r * w0[1] * bfhi(zz[q].x)); w.y = cvt_pk_bf16(o[2] * r * w0[2] * bflo(zz[q].y), o[3] * r * w0[3] * bfhi(zz[q].y));
            w.z = cvt_pk_bf16(o[4] * r * w1[0] * bflo(zz[q].z), o[5] * r * w1[1] * bfhi(zz[q].z)); w.w = cvt_pk_bf16(o[6] * r * w1[2] * bflo(zz[q].w), o[7] * r * w1[3] * bfhi(zz[q].w));
            *(u32x4*)(ON + (size_t)t * EI + e) = w;
        }
    }
}

__device__ __forceinline__ void final_norm(const bf16_t* __restrict__ xb, float* __restrict__ out, const float* __restrict__ fw) {
    const int lane = threadIdx.x & 63, gw = blockIdx.x * 8 + (threadIdx.x >> 6), nw_ = gridDim.x * 8;
    f32x4 wv[4];
#pragma unroll
    for (int i = 0; i < 4; ++i) wv[i] = *(const f32x4*)(fw + i * 256 + lane * 4);
    for (int row = gw; row < MT; row += 2 * nw_) {
        u32x2 v[2][4];
#pragma unroll
        for (int q = 0; q < 2; ++q)
#pragma unroll
            for (int i = 0; i < 4; ++i) v[q][i] = *(const u32x2*)(xb + (size_t)(row + q * nw_) * DM + i * 256 + lane * 4);
#pragma unroll
        for (int q = 0; q < 2; ++q) {
            f32x4 f[4]; float ss = 0.f;
#pragma unroll
            for (int i = 0; i < 4; ++i) { f[i] = (f32x4){bflo(v[q][i].x), bfhi(v[q][i].x), bflo(v[q][i].y), bfhi(v[q][i].y)}; ss += (f[i][0] * f[i][0] + f[i][1] * f[i][1]) + (f[i][2] * f[i][2] + f[i][3] * f[i][3]); }
#pragma unroll
            for (int o = 32; o >= 1; o >>= 1) ss += __shfl_xor(ss, o);
            const float r = rsqrtf(ss * (1.0f / DM) + EPSV);
#pragma unroll
            for (int i = 0; i < 4; ++i) *(f32x4*)(out + (size_t)(row + q * nw_) * DM + i * 256 + lane * 4) = f[i] * r * wv[i];
        }
    }
}


#define XB_TMO      128
#define XB_XCNT(j)  (256  + 64 * (j))
#define XB_XSUB(j)  (1280 + 64 * (j))
#define XB_XGEN(j)  (2304 + 64 * (j))
#define XB_TOP      3328
#define XB_TOPGEN   3392
#define XCD_BAR_WORDS 3456
#define XB_SPIN_CAP (1u << 18)
__device__ __forceinline__ unsigned xb_ld(unsigned* p)              { return __hip_atomic_load(p, __ATOMIC_RELAXED, __HIP_MEMORY_SCOPE_AGENT); }
__device__ __forceinline__ unsigned xb_add(unsigned* p, unsigned v) { return __hip_atomic_fetch_add(p, v, __ATOMIC_RELAXED, __HIP_MEMORY_SCOPE_AGENT); }
__device__ __forceinline__ unsigned xb_xcc_id() { return (unsigned)__builtin_amdgcn_s_getreg((3 << 11) | 20) & 0xFu; }
#define XB_SPIN(cond, bar) do { unsigned _sp = 0; while (cond) { __builtin_amdgcn_s_sleep(1); \
    if ((++_sp & 255u) == 0u) { if (xb_ld(&(bar)[XB_TMO])) break; if (_sp > XB_SPIN_CAP) { atomicAdd(&(bar)[XB_TMO], 1u); break; } } } } while (0)
struct XcdBarrier { unsigned* bar; unsigned x; volatile LAS unsigned* st; };
__device__ __forceinline__ XcdBarrier xcd_barrier_post(unsigned* bar, volatile LAS unsigned* st) {
    XcdBarrier b; b.bar = bar; b.x = xb_xcc_id(); b.st = st;
    if (threadIdx.x == 0) (void)xb_add(&bar[XB_XCNT(b.x)], 1u);
    return b;
}
__device__ __forceinline__ void xcd_barrier_complete(unsigned* bar, unsigned x, unsigned& nloc, unsigned& nx) {
    const unsigned G = gridDim.x * gridDim.y * gridDim.z;
    unsigned sum, cnt, mine, sp = 0u;
    for (;;) {
        sum = 0u; cnt = 0u; mine = 0u;
#pragma unroll
        for (unsigned j = 0; j < 16; ++j) { const unsigned c = xb_ld(&bar[XB_XCNT(j)]); sum += c; cnt += (c > 0u) ? 1u : 0u; mine = (j == x) ? c : mine; }
        if (sum == G) break;
        __builtin_amdgcn_s_sleep(1);
        if ((++sp & 255u) == 0u) { if (xb_ld(&bar[XB_TMO])) break; if (sp > XB_SPIN_CAP) { atomicAdd(&bar[XB_TMO], 1u); break; } }
    }
    nloc = mine > 0u ? mine : 1u; nx = cnt > 0u ? cnt : 1u;
}
__device__ __forceinline__ void xcd_barrier(const XcdBarrier& b) {
    asm volatile("s_waitcnt vmcnt(0)" ::: "memory");
    __syncthreads();
    if (threadIdx.x == 0) {
        unsigned* bar = b.bar;
        __builtin_amdgcn_s_waitcnt(0);
        unsigned nloc = b.st[0], nx = b.st[1];
        if (nloc == 0u) { xcd_barrier_complete(bar, b.x, nloc, nx); b.st[0] = nloc; b.st[1] = nx; }
        const unsigned old = xb_add(&bar[XB_XSUB(b.x)], 1u);
        const unsigned gen = old / nloc;
        if (old + 1u == (gen + 1u) * nloc) {
            __builtin_amdgcn_fence(__ATOMIC_RELEASE, "agent");
            asm volatile("s_waitcnt vmcnt(0)" ::: "memory");
            const unsigned og = xb_add(&bar[XB_TOP], 1u);
            const unsigned tg = og / nx;
            if (og + 1u == (tg + 1u) * nx) xb_add(&bar[XB_TOPGEN], 1u);
            else XB_SPIN(xb_ld(&bar[XB_TOPGEN]) == tg, bar);
            __builtin_amdgcn_fence(__ATOMIC_ACQUIRE, "agent");
            xb_add(&bar[XB_XGEN(b.x)], 1u);
            asm volatile("s_waitcnt vmcnt(0)" ::: "memory");
        } else {
            XB_SPIN(xb_ld(&bar[XB_XGEN(b.x)]) == gen, bar);
            __builtin_amdgcn_fence(__ATOMIC_ACQUIRE, "agent");
            asm volatile("s_waitcnt vmcnt(0)" ::: "memory");
        }
    }
    __syncthreads();
}

__device__ __forceinline__ void grid_barrier(cg::grid_group& grid) {
    asm volatile("s_waitcnt vmcnt(0) lgkmcnt(0)" ::: "memory");
    grid.sync();
    __builtin_amdgcn_fence(__ATOMIC_ACQUIRE, "agent");
    asm volatile("s_waitcnt vmcnt(0)" ::: "memory");
}
__global__ void __launch_bounds__(512, 2) fwd_megakernel(Params P) {
    extern __shared__ __attribute__((aligned(16))) unsigned char lds_raw[];
    LAS unsigned char* lds = (LAS unsigned char*)lds_raw;
    cg::grid_group grid = cg::this_grid();
    const int G = gridDim.x, bid = blockIdx.x;
    unsigned char* ws = P.ws;
    bf16_t* xb = (bf16_t*)(ws + WS_XB); float* rs = (float*)(ws + WS_RS);

    volatile LAS unsigned* xbst = (volatile LAS unsigned*)(lds + pg8::STAGE_BYTES);
    if (threadIdx.x == 0) { xbst[0] = 0u; xbst[1] = 0u; xbst[2] = 0u; xbst[3] = 0u; }
    __syncthreads();
    const XcdBarrier xbar = xcd_barrier_post((unsigned*)(ws + WS_BAR), xbst);
    prologue(P, lds);
    if (P.never) grid_barrier(grid);
    xcd_barrier(xbar);

#pragma nounroll
    for (int layer = 0; layer < DBG_LAYERS; ++layer) {
        const int j = layer >> 1;
        if ((layer & 1) == 0) {
            bf16_t* VE = (bf16_t*)(ws + WS_CV); bf16_t* GE = (bf16_t*)(ws + WS_CV + 16 * MiB); bf16_t* Gb = (bf16_t*)(ws + WS_CG);
            {
                pg8::Gemm g{xb, (const bf16_t*)(ws + WS_WCIN) + (size_t)j * 8192 * DM, MT, 8192, DM}; pg8::StaticOrder S; S.init(MT, 8192, G, bid);
                const RCtx rc = fill_row_scales(lds, S, rs, 0);
                EpiConv1 E{rs, Gb, VE, GE, P.conv_kernel + (size_t)j * 3 * EI, rc, (bf16_t*)P.out};
                pg8::gemm_phase<EpiConv1>(lds, g, S, E);
            }
            xcd_barrier(xbar);
            conv_fix(Gb, (bf16_t*)P.out, VE, GE, P.conv_kernel + (size_t)j * 3 * EI);
            xcd_barrier(xbar);
            {
                pg8::Gemm g{Gb, (const bf16_t*)(ws + WS_WCOUT) + (size_t)j * DM * EI, MH, DM, EI}; pg8::StaticOrder S; S.init(MH, DM, G, bid);
                EpiRes E{xb, rs, 0};
                pg8::gemm_phase<EpiRes>(lds, g, S, E);
            }
            xcd_barrier(xbar);
        } else {
            bf16_t* QEF = (bf16_t*)(ws + WS_QEF); bf16_t* KIF = (bf16_t*)(ws + WS_KIF); bf16_t* QEB = (bf16_t*)(ws + WS_QEB); bf16_t* KIB = (bf16_t*)(ws + WS_KIB); bf16_t* VV = (bf16_t*)(ws + WS_VV);
            float* DLF = (float*)(ws + WS_DLF); float* DLB = (float*)(ws + WS_DLB);
            bf16_t* Y0 = (bf16_t*)P.out + (size_t)MH * EI;
            const bf16_t* Win = (const bf16_t*)(ws + WS_WHIN) + (size_t)j * 10240 * DM;
#pragma nounroll
            for (int half = 0; half < 2; ++half) {
                const int rb = half * MH;
                {
                    pg8::Gemm g{xb + (size_t)rb * DM, Win, MH, 8192, DM}; pg8::StaticOrder S; S.init(MH, 8192, G, bid);
                    const RCtx rc = fill_row_scales(lds, S, rs, rb);
                    EpiH1 E{rs, P.hgrn_lb, j, rb, QEF, KIF, QEB, KIB, VV, DLF, DLB, (bf16_t*)P.out, rc};
                    pg8::gemm_phase<EpiH1>(lds, g, S, E);
                }
                xcd_barrier(xbar);
                if (bid < 128 || G < 256) {
                    scan_phase(lds, QEF, KIF, QEB, KIB, VV, DLF, DLB);
                }
                if (bid >= 128 || G < 256) {
                    const int Gz = (G < 256) ? G : G - 128, cz = (G < 256) ? bid : bid - 128;
                    pg8::Gemm g{xb + (size_t)rb * DM, Win + (size_t)8192 * DM, MH, EI, DM}; pg8::StaticOrder S; S.init(MH, EI, Gz, cz);
                    const RCtx rc = fill_row_scales(lds, S, rs, rb);
                    EpiSZ E{rs, rb, (bf16_t*)P.out, rc};
                    pg8::gemm_phase<EpiSZ>(lds, g, S, E);
                    if (half == 0) {
                        pg8::Gemm g2{(const bf16_t*)P.out + (size_t)MH * EI, (const bf16_t*)(ws + WS_WCOUT) + (size_t)j * DM * EI, MH, DM, EI}; pg8::StaticOrder S2; S2.init(MH, DM, Gz, cz);
                        EpiRes E2{xb, rs, MH};
                        pg8::gemm_phase<EpiRes>(lds, g2, S2, E2);
                    }
                    if (half == 1) {
                        pg8::Gemm g2{Y0, (const bf16_t*)(ws + WS_WHOUT) + (size_t)j * DM * EI, MH, DM, EI}; pg8::StaticOrder S2; S2.init(MH, DM, Gz, cz);
                        EpiRes E2{xb, rs, 0};
                        pg8::gemm_phase<EpiRes>(lds, g2, S2, E2);
                    }
                }
                xcd_barrier(xbar);
                combine_phase(QEF, QEB, (const bf16_t*)P.out, (half == 0) ? Y0 : VV, P.hgrn_norm_w + (size_t)j * EI);
                xcd_barrier(xbar);
                if (half == 1) {
                    pg8::Gemm g{VV, (const bf16_t*)(ws + WS_WHOUT) + (size_t)j * DM * EI, MH, DM, EI}; pg8::StaticOrder S; S.init(MH, DM, G, bid);
                    EpiRes E{xb, rs, rb};
                    pg8::gemm_phase<EpiRes>(lds, g, S, E);
                    xcd_barrier(xbar);
                }
            }
        }
    }
    if (DBG_LAYERS == 0) { const size_t n = (size_t)MT * DM; for (size_t i = (size_t)blockIdx.x * 512 + threadIdx.x; i < n; i += (size_t)gridDim.x * 512) P.out[i] = P.x[i]; xcd_barrier(xbar); }
    final_norm(xb, P.out, P.final_norm_w);
}

extern "C" void kernel_launch(void* const* d_in, const int* in_sizes, int n_in, void* d_out, int out_size, void* d_ws, size_t ws_size, hipStream_t stream) {
    constexpr size_t kDynLds = pg8::STAGE_BYTES + 16 + 2048;
    static int grid_blocks = 0;
    if (!grid_blocks) {
        if (ws_size < WS_END) { fprintf(stderr, "kernel_launch: workspace too small: %zu < %zu\n", ws_size, (size_t)WS_END); grid_blocks = -1; return; }
        int dev = 0, cus = 0, per_cu = 0;
        hipGetDevice(&dev);
        hipDeviceGetAttribute(&cus, hipDeviceAttributeMultiprocessorCount, dev);
        if (hipFuncSetAttribute((const void*)fwd_megakernel, hipFuncAttributeMaxDynamicSharedMemorySize, (int)kDynLds) != hipSuccess) { fprintf(stderr, "kernel_launch: hipFuncSetAttribute failed\n"); grid_blocks = -1; return; }
        hipOccupancyMaxActiveBlocksPerMultiprocessor(&per_cu, (const void*)fwd_megakernel, 512, kDynLds);
        if (per_cu < 1) per_cu = 1;
        grid_blocks = cus * per_cu;
        if (grid_blocks > 256) grid_blocks = 256;
        (void)hipGetLastError();
    }
    if (grid_blocks < 0) return;
    if (hipMemsetAsync((char*)d_ws + WS_BAR, 0, 16384, stream) != hipSuccess) { fprintf(stderr, "kernel_launch: memset of barrier words failed\n"); return; }
    Params p{};
    p.x = (const float*)d_in[0]; p.norm_w = (const float*)d_in[1]; p.final_norm_w = (const float*)d_in[2]; p.conv_w_in = (const float*)d_in[3]; p.conv_kernel = (const float*)d_in[4];
    p.conv_w_out = (const float*)d_in[5]; p.hgrn_w_in = (const float*)d_in[6]; p.hgrn_lb = (const float*)d_in[7]; p.hgrn_norm_w = (const float*)d_in[8]; p.hgrn_w_out = (const float*)d_in[9];
    p.out = (float*)d_out; p.ws = (unsigned char*)d_ws;
    void* args[] = {&p};
    hipError_t e = hipLaunchCooperativeKernel((void*)fwd_megakernel, dim3(grid_blocks), dim3(512), args, kDynLds, stream);
    if (e != hipSuccess) fprintf(stderr, "cooperative launch failed: %s (grid %d)\n", hipGetErrorString(e), grid_blocks);
}
```

```cpp
#include <hip/hip_runtime.h>
#include <hip/hip_cooperative_groups.h>
#include <cstdio>
namespace cg = cooperative_groups;
#ifndef DBG_LAYERS
#define DBG_LAYERS 4
#endif

#define LAS __attribute__((address_space(3)))
typedef unsigned short bf16_t;
typedef short bf16x8 __attribute__((ext_vector_type(8)));
typedef short bf16x4 __attribute__((ext_vector_type(4)));
typedef float f32x4 __attribute__((ext_vector_type(4)));
typedef unsigned u32x4 __attribute__((ext_vector_type(4)));
typedef unsigned u32x2 __attribute__((ext_vector_type(2)));

constexpr int DM = 1024, EI = 2048, SEQ = 4096, NB = 8, MT = NB * SEQ  , MH = MT / 2;
constexpr float EPSV = 1e-6f;
constexpr size_t MiB = 1024ull * 1024ull;
constexpr size_t WS_XB = 0;
constexpr size_t WS_WCIN = WS_XB + 64 * MiB;
constexpr size_t WS_WCOUT = WS_WCIN + 32 * MiB;
constexpr size_t WS_WHIN = WS_WCOUT + 8 * MiB;
constexpr size_t WS_WHOUT = WS_WHIN + 40 * MiB;
constexpr size_t WS_RS = WS_WHOUT + 8 * MiB;
constexpr size_t WS_BIG = WS_RS + 2 * MiB;
constexpr size_t WS_CV = WS_BIG;
constexpr size_t WS_CG = WS_BIG + 128 * MiB;
constexpr size_t WS_QEF = WS_BIG;
constexpr size_t WS_KIF = WS_BIG + 64 * MiB;
constexpr size_t WS_QEB = WS_BIG + 128 * MiB;
constexpr size_t WS_KIB = WS_BIG + 192 * MiB;
constexpr size_t WS_VV = WS_BIG + 256 * MiB;
constexpr size_t WS_DLF = WS_BIG + 320 * MiB;
constexpr size_t WS_DLB = WS_BIG + 324 * MiB;
constexpr size_t WS_BAR = WS_BIG + 328 * MiB;
constexpr size_t WS_END = WS_BAR + 16384;

typedef __bf16 bf16v2_t __attribute__((ext_vector_type(2)));
typedef float f32x2_t __attribute__((ext_vector_type(2)));
__device__ __forceinline__ unsigned cvt_pk_bf16(float lo, float hi) { const f32x2_t v = {lo, hi}; return __builtin_bit_cast(unsigned, __builtin_convertvector(v, bf16v2_t)); }
__device__ __forceinline__ float bflo(unsigned w) { return __uint_as_float(w << 16); }
__device__ __forceinline__ float bfhi(unsigned w) { return __uint_as_float(w & 0xffff0000u); }
__device__ __forceinline__ float fast_exp2(float x) { return __builtin_amdgcn_exp2f(x); }
__device__ __forceinline__ float fast_exp(float x) { return __builtin_amdgcn_exp2f(x * 1.44269504089f); }
__device__ __forceinline__ float fast_rcp(float x) { return __builtin_amdgcn_rcpf(x); }
template <int CTRL> __device__ __forceinline__ float dppf(float x) { return __int_as_float(__builtin_amdgcn_update_dpp(0, __float_as_int(x), CTRL, 0xf, 0xf, false)); }
__device__ __forceinline__ float row_prefix16(float x) { x += dppf<0x111>(x); x += dppf<0x112>(x); x += dppf<0x114>(x); x += dppf<0x118>(x); return x; }
template <int CTRL> __device__ __forceinline__ float dppf1(float x) { return __int_as_float(__builtin_amdgcn_update_dpp(0x3f800000, __float_as_int(x), CTRL, 0xf, 0xf, false)); }
__device__ __forceinline__ float row_prefprod16(float x) { x *= dppf1<0x111>(x); x *= dppf1<0x112>(x); x *= dppf1<0x114>(x); x *= dppf1<0x118>(x); return x; }
__device__ __forceinline__ float row_sufprod16(float x) { x *= dppf1<0x101>(x); x *= dppf1<0x102>(x); x *= dppf1<0x104>(x); x *= dppf1<0x108>(x); return x; }
__device__ __forceinline__ float row_suffix16(float x) { x += dppf<0x101>(x); x += dppf<0x102>(x); x += dppf<0x104>(x); x += dppf<0x108>(x); return x; }

namespace pg8 {
constexpr int BM = 256, BK = 64, HALF = 128, HTB = HALF * BK * 2, STAGE_BYTES = 8 * HTB, NXCD = 8, WGM = 8;
__host__ __device__ __forceinline__ int lds_byte(int r, int c) { const int st = (r >> 4) * 2 + (c >> 5), rr = r & 15, cc = c & 31, ob = rr * 64 + cc * 2; return st * 1024 + (ob ^ (((ob >> 9) & 1) << 5)); }
__host__ __device__ __forceinline__ void stage_rc(int b, int& R, int& C) { const int st = b / 1024, sb = b % 1024, swz = sb ^ (((sb >> 9) & 1) << 5); R = (st >> 1) * 16 + swz / 64; C = (st & 1) * 32 + (swz % 64) / 2; }
struct Unit { int pm, pn; };
struct Gemm { const bf16_t* A; const bf16_t* Bt; int M, N, K; };
struct StaticOrder {
    int nM, nN, nwg, G, c, wgm;
    __host__ __device__ void init(int M, int N, int G_, int c_, int wgm_ = WGM) { nM = M / BM; nN = N / BM; nwg = nM * nN; G = G_; c = c_; wgm = wgm_; }
    __host__ __device__ bool next(int i, Unit& u) const {
        const long L = (long)i * G + c; if (L >= nwg) return false;
        int wgid = (int)L; { const int q = nwg / NXCD, r = nwg % NXCD, xcd = wgid % NXCD, off = wgid / NXCD; wgid = (xcd < r ? xcd * (q + 1) : r * (q + 1) + (xcd - r) * q) + off; }
        const int nig = wgm * nN, gid = wgid / nig, fm = gid * wgm, gsz = (nM - fm) < wgm ? (nM - fm) : wgm;
        u.pm = fm + ((wgid % nig) % gsz); u.pn = (wgid % nig) / gsz; return true;
    }
};
template <class Epi>
__device__ __forceinline__ void gemm_phase(LAS unsigned char* lds, const Gemm g, const StaticOrder& S, const Epi& E) {
    int tid = threadIdx.x; asm volatile("" : "+v"(tid));
    const int wid = __builtin_amdgcn_readfirstlane(tid >> 6), lane = tid & 63, wr = wid >> 2, wc = wid & 3, fr = lane & 15, fq = lane >> 4;
    const int K = g.K, nt = K / BK;
    unsigned voffA[2];
#pragma unroll
    for (int i = 0; i < 2; ++i) { int R, C; stage_rc(tid * 16 + i * 8192, R, C); voffA[i] = (unsigned)(R * K + C) * 2u; }
    const size_t kstep = (size_t)(BK * 2);
    const size_t hstep = (size_t)HALF * K * 2;
    const size_t tstep = 2 * hstep;
    const unsigned ldsw = (unsigned)wid * 1024u;
    const int aoff = lds_byte(wr * 64 + fr, fq * 8), boff = lds_byte(wc * 32 + fr, fq * 8);
#define PG8_SA(b, h) (((b) * 2 + (h)) * HTB)
#define PG8_SB(b, h) ((4 + (b) * 2 + (h)) * HTB)
#define PG8_STAGE(bufoff, gbase, voff) do { _Pragma("unroll") for (int _i = 0; _i < 2; ++_i) \
        __builtin_amdgcn_global_load_lds((const unsigned*)((const char*)(gbase) + (voff)[_i]), (LAS unsigned*)(lds + (bufoff) + ldsw + _i * 8192), 16, 0, 0); } while (0)
#define PG8_LDA(dst, b, h) do { _Pragma("unroll") for (int m = 0; m < 4; ++m) _Pragma("unroll") for (int k = 0; k < 2; ++k) dst[m][k] = *(const LAS bf16x8*)(lds + PG8_SA(b, h) + aoff + m * 2048 + k * 1024); } while (0)
#define PG8_LDB(dst, b, h) do { _Pragma("unroll") for (int n = 0; n < 2; ++n) _Pragma("unroll") for (int k = 0; k < 2; ++k) dst[n][k] = *(const LAS bf16x8*)(lds + PG8_SB(b, h) + boff + n * 2048 + k * 1024); } while (0)
#define PG8_MMA(ai, bj, At, Bt) do { __builtin_amdgcn_s_setprio(1); _Pragma("unroll") for (int m = 0; m < 4; ++m) _Pragma("unroll") for (int n = 0; n < 2; ++n) _Pragma("unroll") for (int k = 0; k < 2; ++k) \
        acc[ai][bj][m][n] = __builtin_amdgcn_mfma_f32_16x16x32_bf16(Bt[n][k], At[m][k], acc[ai][bj][m][n], 0, 0, 0); __builtin_amdgcn_s_setprio(0); } while (0)
#define PG8_WAIT_V(n) asm volatile("s_waitcnt vmcnt(" #n ")" ::: "memory")
#define PG8_WAIT_L(n) asm volatile("s_waitcnt lgkmcnt(" #n ")" ::: "memory")
#define PG8_BAR __builtin_amdgcn_s_barrier()
#define PG8_SCHED __builtin_amdgcn_sched_barrier(0)
    Unit cur, nxt; int ui = 0;
    if (!S.next(0, cur)) return;
    f32x4 acc[2][2][4][2];
#pragma unroll
    for (int a = 0; a < 2; ++a)
#pragma unroll
        for (int b = 0; b < 2; ++b)
#pragma unroll
            for (int m = 0; m < 4; ++m)
#pragma unroll
                for (int n = 0; n < 2; ++n) acc[a][b][m][n] = (f32x4){0.f, 0.f, 0.f, 0.f};
    bf16x8 At[4][2], B0[2][2], B1[2][2];
    const char* cA = (const char*)g.A + (size_t)cur.pm * tstep; const char* cB = (const char*)g.Bt + (size_t)cur.pn * tstep;
    PG8_STAGE(PG8_SB(0, 0), cB, voffA); PG8_STAGE(PG8_SB(0, 1), cB + hstep, voffA); PG8_STAGE(PG8_SA(0, 0), cA, voffA); PG8_STAGE(PG8_SA(0, 1), cA + hstep, voffA);
    if (wr == 1) PG8_BAR;
    PG8_WAIT_V(2); PG8_BAR;
    PG8_STAGE(PG8_SB(1, 0), cB + kstep, voffA); PG8_STAGE(PG8_SA(1, 0), cA + kstep, voffA); PG8_STAGE(PG8_SB(1, 1), cB + hstep + kstep, voffA);
    PG8_WAIT_V(6); PG8_BAR;
    for (;;) {
        const bool has_next = S.next(ui + 1, nxt);
        const char* nA = has_next ? (const char*)g.A + (size_t)nxt.pm * tstep : cA; const char* nB = has_next ? (const char*)g.Bt + (size_t)nxt.pn * tstep : cB;
        for (int t = 0; t < nt; t += 2) {
            const bool last = (t == nt - 2);
            const char* a1 = cA + (size_t)(t + 1) * kstep;
            const char* a2 = last ? nA : cA + (size_t)(t + 2) * kstep; const char* b2 = last ? nB : cB + (size_t)(t + 2) * kstep;
            const char* a3 = a2 + kstep; const char* b3 = b2 + kstep;
            PG8_LDB(B0, 0, 0); PG8_LDB(B1, 0, 1); PG8_SCHED; PG8_LDA(At, 0, 0); PG8_STAGE(PG8_SA(1, 1), a1 + hstep, voffA);
            PG8_WAIT_V(8); PG8_WAIT_L(0); PG8_BAR; PG8_MMA(0, 0, At, B0); PG8_MMA(0, 1, At, B1); PG8_BAR; PG8_SCHED;
            PG8_LDA(At, 0, 1); PG8_STAGE(PG8_SB(0, 0), b2, voffA); PG8_STAGE(PG8_SB(0, 1), b2 + hstep, voffA); PG8_STAGE(PG8_SA(0, 0), a2, voffA);
            PG8_WAIT_V(8); PG8_WAIT_L(0); PG8_BAR; PG8_MMA(1, 0, At, B0); PG8_MMA(1, 1, At, B1); PG8_BAR; PG8_SCHED;
            PG8_LDB(B0, 1, 0); PG8_LDB(B1, 1, 1); PG8_SCHED; PG8_LDA(At, 1, 0); PG8_STAGE(PG8_SA(0, 1), a2 + hstep, voffA);
            PG8_WAIT_V(8); PG8_WAIT_L(0); PG8_BAR; PG8_MMA(0, 0, At, B0); PG8_MMA(0, 1, At, B1); PG8_BAR; PG8_SCHED;
            PG8_LDA(At, 1, 1); PG8_STAGE(PG8_SB(1, 0), b3, voffA); PG8_STAGE(PG8_SB(1, 1), b3 + hstep, voffA); PG8_STAGE(PG8_SA(1, 0), a3, voffA);
            PG8_WAIT_V(8); PG8_WAIT_L(0); PG8_BAR; PG8_MMA(1, 0, At, B0); PG8_MMA(1, 1, At, B1); PG8_BAR; PG8_SCHED;
        }
        if (wr == 0) PG8_BAR;
        E(acc, cur, wr, wc, fr, fq);
        if (!has_next) break;
#pragma unroll
        for (int a = 0; a < 2; ++a)
#pragma unroll
            for (int b = 0; b < 2; ++b)
#pragma unroll
                for (int m = 0; m < 4; ++m)
#pragma unroll
                    for (int n = 0; n < 2; ++n) acc[a][b][m][n] = (f32x4){0.f, 0.f, 0.f, 0.f};
        cur = nxt; cA = nA; cB = nB; ++ui;
        if (wr == 1) PG8_BAR;
    }
    PG8_WAIT_V(0);
    PG8_BAR;
#undef PG8_SA
#undef PG8_SB
#undef PG8_STAGE
#undef PG8_LDA
#undef PG8_LDB
#undef PG8_MMA
#undef PG8_WAIT_V
#undef PG8_WAIT_L
#undef PG8_BAR
#undef PG8_SCHED
}
}

__device__ __forceinline__ float row_rscale(const float* __restrict__ rs, int row, int fq) {
    const float* p = rs + (size_t)(4 * fq) * MT + row;
    float s = (p[0] + p[MT]) + (p[2 * (size_t)MT] + p[3 * (size_t)MT]);
    s += __shfl_xor(s, 16); s += __shfl_xor(s, 32);
    return rsqrtf(s * (1.0f / DM) + EPSV);
}
__device__ __forceinline__ void row_rscale8(const float* __restrict__ rs, int row0, int fq, float (&r)[2][4]) {
    float s[2][4];
#pragma unroll
    for (int ai = 0; ai < 2; ++ai)
#pragma unroll
        for (int m = 0; m < 4; ++m) { const float* p = rs + (size_t)(4 * fq) * MT + row0 + ai * 128 + m * 16; s[ai][m] = (p[0] + p[MT]) + (p[2 * (size_t)MT] + p[3 * (size_t)MT]); }
#pragma unroll
    for (int ai = 0; ai < 2; ++ai)
#pragma unroll
        for (int m = 0; m < 4; ++m) { float t = s[ai][m]; t += __shfl_xor(t, 16); t += __shfl_xor(t, 32); r[ai][m] = rsqrtf(t * (1.0f / DM) + EPSV); }
}

__device__ __forceinline__ void store_pair16(bf16_t* xp, bf16_t* yp, u32x2 x, u32x2 y, int fq) {
    const u32x2 r0 = __builtin_amdgcn_permlane16_swap(x.x, y.x, false, false);
    const u32x2 r1 = __builtin_amdgcn_permlane16_swap(x.y, y.y, false, false);
    u32x4 d; d.x = r0.x; d.y = r1.x; d.z = r0.y; d.w = r1.y;
    bf16_t* p = (fq & 1) ? (yp - 4) : xp;
    *(u32x4*)p = d;
}

struct RCtx { const LAS float* rl; int pmA, pmB; };
__device__ __forceinline__ RCtx fill_row_scales(LAS unsigned char* lds, const pg8::StaticOrder& S, const float* __restrict__ rs, int row_base) {
    RCtx rc; rc.rl = (const LAS float*)(lds + pg8::STAGE_BYTES + 16); rc.pmA = 0; rc.pmB = 0;
    pg8::Unit u0, ul;
    if (S.next(0, u0)) {
        const int nun = (int)(((long)S.nwg - S.c + S.G - 1) / S.G); S.next(nun - 1, ul);
        rc.pmA = u0.pm; rc.pmB = ul.pm;
        const int tid = threadIdx.x, pm = (tid >> 8) ? ul.pm : u0.pm;
        const float* p = rs + (size_t)(row_base + pm * 256 + (tid & 255));
        float s0 = 0.f, s1 = 0.f, s2 = 0.f, s3 = 0.f;
#pragma unroll
        for (int k = 0; k < 4; ++k) { s0 += p[(size_t)(4 * k) * MT]; s1 += p[(size_t)(4 * k + 1) * MT]; s2 += p[(size_t)(4 * k + 2) * MT]; s3 += p[(size_t)(4 * k + 3) * MT]; }
        ((LAS float*)(lds + pg8::STAGE_BYTES + 16))[tid] = rsqrtf(((s0 + s1) + (s2 + s3)) * (1.0f / DM) + EPSV);
    }
    __syncthreads();
    return rc;
}
__device__ __forceinline__ void row_rscale8c(const RCtx& rc, const float* __restrict__ rs, int grow0, int pm, int lr0, int fq, float (&r)[2][4]) {
    if (pm == rc.pmA || pm == rc.pmB) {
        const LAS float* p = rc.rl + ((pm == rc.pmA) ? 0 : 256) + lr0;
#pragma unroll
        for (int ai = 0; ai < 2; ++ai)
#pragma unroll
            for (int m = 0; m < 4; ++m) r[ai][m] = p[ai * 128 + m * 16];
    } else row_rscale8(rs, grow0, fq, r);
}

struct EpiConv1 {
    const float* rs; bf16_t* Y; bf16_t* VE; bf16_t* GE; const float* ck; RCtx rc; bf16_t* Yhi;
    __device__ __forceinline__ void operator()(const f32x4 (&acc)[2][2][4][2], const pg8::Unit& u, int wr, int wc, int fr, int fq) const {
        const int e0 = u.pn * 64 + wc * 16 + fq * 4;
        float rsc[2][4]; row_rscale8c(rc, rs, u.pm * 256 + wr * 64 + fr, u.pm, wr * 64 + fr, fq, rsc);
        const f32x4 k0 = *(const f32x4*)(ck + e0), k1 = *(const f32x4*)(ck + EI + e0), k2 = *(const f32x4*)(ck + 2 * EI + e0);
#pragma unroll
        for (int ai = 0; ai < 2; ++ai) {
            float v[4][4], gg[4][4];
#pragma unroll
            for (int m = 0; m < 4; ++m) {
                const float r = rsc[ai][m];
                const f32x4 b = acc[ai][0][m][0] * r, c = acc[ai][0][m][1] * r, uu = acc[ai][1][m][0] * r, z = acc[ai][1][m][1] * r;
#pragma unroll
                for (int j = 0; j < 4; ++j) { v[m][j] = c[j] * uu[j]; gg[m][j] = b[j] * z[j] * fast_rcp(1.0f + fast_exp(-z[j])); }
            }
            const int blk = u.pm * 4 + ai * 2 + wr;
#pragma unroll
            for (int m = 0; m < 4; ++m) {
                const int row = u.pm * 256 + ai * 128 + wr * 64 + m * 16 + fr;
                float y[4];
#pragma unroll
                for (int j = 0; j < 4; ++j) {
                    const float pown = dppf<0x121>(v[m][j]);
                    const float pup = (m > 0) ? dppf<0x121>(v[m > 0 ? m - 1 : 0][j]) : 0.f;
                    const float nown = dppf<0x12f>(v[m][j]);
                    const float ndn = (m < 3) ? dppf<0x12f>(v[m < 3 ? m + 1 : 3][j]) : 0.f;
                    const float prev = (fr > 0) ? pown : pup, next = (fr < 15) ? nown : ndn;
                    y[j] = gg[m][j] * (k0[j] * prev + k1[j] * v[m][j] + k2[j] * next);
                }
                u32x2 wy; wy.x = cvt_pk_bf16(y[0], y[1]); wy.y = cvt_pk_bf16(y[2], y[3]);
                *(u32x2*)(((u.pm >= MH / 256) ? Yhi : Y) + (size_t)row * EI + e0) = wy;
                if (m == 0 || m == 3) {
                    u32x2 wv, wg; wv.x = cvt_pk_bf16(v[m][0], v[m][1]); wv.y = cvt_pk_bf16(v[m][2], v[m][3]); wg.x = cvt_pk_bf16(gg[m][0], gg[m][1]); wg.y = cvt_pk_bf16(gg[m][2], gg[m][3]);
                    if (m == 0 && fr < 2) *(u32x2*)(VE + ((size_t)blk * 4 + 2 + fr) * EI + e0) = wv;
                    if (m == 3 && fr >= 14) *(u32x2*)(VE + ((size_t)blk * 4 + (fr - 14)) * EI + e0) = wv;
                    if (m == 0 && fr == 0) *(u32x2*)(GE + ((size_t)blk * 2 + 1) * EI + e0) = wg;
                    if (m == 3 && fr == 15) *(u32x2*)(GE + ((size_t)blk * 2 + 0) * EI + e0) = wg;
                }
            }
        }
    }
};
struct EpiRes {
    bf16_t* xb; float* rs; int row_base;
    __device__ __forceinline__ void operator()(const f32x4 (&acc)[2][2][4][2], const pg8::Unit& u, int wr, int wc, int fr, int fq) const {
        bf16_t* base = xb + (size_t)(row_base + u.pm * 256 + wr * 64 + fr) * DM + u.pn * 256 + wc * 32 + fq * 4;
#pragma unroll
        for (int ai = 0; ai < 2; ++ai) {
            u32x2 xr[4][2][2];
#pragma unroll
            for (int m = 0; m < 4; ++m)
#pragma unroll
                for (int bj = 0; bj < 2; ++bj)
#pragma unroll
                    for (int n = 0; n < 2; ++n) xr[m][bj][n] = *(const u32x2*)(base + (size_t)(ai * 128 + m * 16) * DM + bj * 128 + n * 16);
#pragma unroll
            for (int m = 0; m < 4; ++m) {
                const int row = row_base + u.pm * 256 + ai * 128 + wr * 64 + m * 16 + fr;
                float ss = 0.f;
#pragma unroll
                for (int bj = 0; bj < 2; ++bj) {
                    u32x2 wn[2];
#pragma unroll
                    for (int n = 0; n < 2; ++n) {
                        const u32x2 xo = xr[m][bj][n]; const f32x4 a = acc[ai][bj][m][n];
                        const float x0 = bflo(xo.x) + a[0], x1 = bfhi(xo.x) + a[1], x2 = bflo(xo.y) + a[2], x3 = bfhi(xo.y) + a[3];
                        wn[n].x = cvt_pk_bf16(x0, x1); wn[n].y = cvt_pk_bf16(x2, x3);
                        ss += (x0 * x0 + x1 * x1) + (x2 * x2 + x3 * x3);
                    }
                    bf16_t* q = base + (size_t)(ai * 128 + m * 16) * DM + bj * 128;
                    store_pair16(q, q + 16, wn[0], wn[1], fq);
                }
                ss += __shfl_xor(ss, 16); ss += __shfl_xor(ss, 32);
                if (fq == 0) rs[(size_t)(u.pn * 4 + wc) * MT + row] = ss;
            }
        }
    }
};
struct EpiZ {
    const float* rs; bf16_t* ON; int row_base;
    __device__ __forceinline__ void operator()(const f32x4 (&acc)[2][2][4][2], const pg8::Unit& u, int wr, int wc, int fr, int fq) const {
        bf16_t* base = ON + (size_t)(u.pm * 256 + wr * 64 + fr) * EI + u.pn * 256 + wc * 32 + fq * 4;
        float rsc[2][4]; row_rscale8(rs, row_base + u.pm * 256 + wr * 64 + fr, fq, rsc);
#pragma unroll
        for (int ai = 0; ai < 2; ++ai) {
            u32x2 xr[4][2][2];
#pragma unroll
            for (int m = 0; m < 4; ++m)
#pragma unroll
                for (int bj = 0; bj < 2; ++bj)
#pragma unroll
                    for (int n = 0; n < 2; ++n) xr[m][bj][n] = *(const u32x2*)(base + (size_t)(ai * 128 + m * 16) * EI + bj * 128 + n * 16);
#pragma unroll
            for (int m = 0; m < 4; ++m) {
                const float r = rsc[ai][m];
#pragma unroll
                for (int bj = 0; bj < 2; ++bj)
#pragma unroll
                    for (int n = 0; n < 2; ++n) {
                        const u32x2 o = xr[m][bj][n]; const f32x4 z = acc[ai][bj][m][n] * r;
                        const float o0 = bflo(o.x), o1 = bfhi(o.x), o2 = bflo(o.y), o3 = bfhi(o.y);
                        const float y0 = o0 * z[0] * fast_rcp(1.0f + fast_exp(-z[0])), y1 = o1 * z[1] * fast_rcp(1.0f + fast_exp(-z[1]));
                        const float y2 = o2 * z[2] * fast_rcp(1.0f + fast_exp(-z[2])), y3 = o3 * z[3] * fast_rcp(1.0f + fast_exp(-z[3]));
                        u32x2 w; w.x = cvt_pk_bf16(y0, y1); w.y = cvt_pk_bf16(y2, y3);
                        *(u32x2*)(base + (size_t)(ai * 128 + m * 16) * EI + bj * 128 + n * 16) = w;
                    }
            }
        }
    }
};
__device__ __forceinline__ size_t hm_off(int lrow, int e) { return (size_t)(lrow >> 12) * ((size_t)EI * SEQ) + (size_t)(e >> 7) * ((size_t)SEQ * 128) + (size_t)(lrow & (SEQ - 1)) * 128 + (e & 127); }
struct EpiH1 {
    const float* rs; const float* lbl; int layer_j; int row_base;
    bf16_t *QEF, *KIF, *QEB, *KIB, *VV; float *DLF, *DLB; bf16_t* SZ; RCtx rc;
    __device__ __forceinline__ void operator()(const f32x4 (&acc)[2][2][4][2], const pg8::Unit& u, int wr, int wc, int fr, int fq) const {
        if (u.pn >= 32) {
            float rz[2][4]; row_rscale8c(rc, rs, row_base + u.pm * 256 + wr * 64 + fr, u.pm, wr * 64 + fr, fq, rz);
            bf16_t* base = SZ + (size_t)(u.pm * 256 + wr * 64 + fr) * EI + (u.pn - 32) * 256 + wc * 32 + fq * 4;
#pragma unroll
            for (int ai = 0; ai < 2; ++ai)
#pragma unroll
                for (int m = 0; m < 4; ++m)
#pragma unroll
                    for (int bj = 0; bj < 2; ++bj) {
                        u32x2 wn[2];
#pragma unroll
                        for (int n = 0; n < 2; ++n) {
                            const f32x4 z = acc[ai][bj][m][n] * rz[ai][m];
                            const float y0 = z[0] * fast_rcp(1.0f + fast_exp(-z[0])), y1 = z[1] * fast_rcp(1.0f + fast_exp(-z[1]));
                            const float y2 = z[2] * fast_rcp(1.0f + fast_exp(-z[2])), y3 = z[3] * fast_rcp(1.0f + fast_exp(-z[3]));
                            wn[n].x = cvt_pk_bf16(y0, y1); wn[n].y = cvt_pk_bf16(y2, y3);
                        }
                        bf16_t* q = base + (size_t)(ai * 128 + m * 16) * EI + bj * 128;
                        store_pair16(q, q + 16, wn[0], wn[1], fq);
                    }
            return;
        }
        const int e0 = u.pn * 64 + wc * 16 + fq * 4;
        float oml[4];
#pragma unroll
        for (int j = 0; j < 4; ++j) {
            float lb = 0.f;
            if (layer_j == 1) { const float l0 = lbl[e0 + j], l1 = lbl[EI + e0 + j], mx = fmaxf(l0, l1), a0 = __expf(l0 - mx), a1 = __expf(l1 - mx), sm = a0 + a1, p0 = a0 / sm, p1 = a1 / sm; lb = (p0 + p1) - p0; }
            lb = fminf(fmaxf(lb, 0.f), 1.0f - 1e-6f);
            oml[j] = 1.0f - lb;
        }
        const float qscale = 0.08838834764831845f;
        float rsc[2][4]; row_rscale8c(rc, rs, row_base + u.pm * 256 + wr * 64 + fr, u.pm, wr * 64 + fr, fq, rsc);
#pragma unroll
        for (int ai = 0; ai < 2; ++ai)
#pragma unroll
            for (int mm = 0; mm < 2; ++mm) {
                const int m0 = 2 * mm, m1 = 2 * mm + 1;
                const int lrow0 = u.pm * 256 + ai * 128 + wr * 64 + m0 * 16 + fr, lrow1 = lrow0 + 16;
                const float r0 = rsc[ai][m0], r1 = rsc[ai][m1], r0l = r0 * 1.44269504089f, r1l = r1 * 1.44269504089f;
                float qf0[4], qf1[4], kf0[4], kf1[4], qb0[4], qb1[4], kb0[4], kb1[4], dlf[4], dlb[4];
#pragma unroll
                for (int j = 0; j < 4; ++j) {
                    const float q0 = acc[ai][0][m0][0][j] * (r0 * qscale), q1 = acc[ai][0][m1][0][j] * (r1 * qscale);
                    {
                        const float k0 = oml[j] * fast_rcp(1.0f + fast_exp2(acc[ai][0][m0][1][j] * r0l)), k1 = oml[j] * fast_rcp(1.0f + fast_exp2(acc[ai][0][m1][1][j] * r1l));
                        const float e0_ = row_prefprod16(1.0f - k0); const float e1_ = row_prefprod16(1.0f - k1) * dppf<0x15f>(e0_);
                        const float E0 = fmaxf(e0_, 1e-30f), E1 = fmaxf(e1_, 1e-30f);
                        qf0[j] = q0 * E0; qf1[j] = q1 * E1; kf0[j] = k0 * fast_rcp(E0); kf1[j] = k1 * fast_rcp(E1);
                        dlf[j] = E1;
                    }
                    {
                        const float k0 = oml[j] * fast_rcp(1.0f + fast_exp2(acc[ai][1][m0][0][j] * r0l)), k1 = oml[j] * fast_rcp(1.0f + fast_exp2(acc[ai][1][m1][0][j] * r1l));
                        const float e1_ = row_sufprod16(1.0f - k1); const float e0_ = row_sufprod16(1.0f - k0) * dppf<0x150>(e1_);
                        const float E0 = fmaxf(e0_, 1e-30f), E1 = fmaxf(e1_, 1e-30f);
                        qb0[j] = q0 * E0; qb1[j] = q1 * E1; kb0[j] = k0 * fast_rcp(E0); kb1[j] = k1 * fast_rcp(E1);
                        dlb[j] = E0;
                    }
                }
                const size_t o0 = hm_off(lrow0, e0), o1 = o0 + 16 * 128;
                u32x2 wa, wb;
                wa.x = cvt_pk_bf16(qf0[0], qf0[1]); wa.y = cvt_pk_bf16(qf0[2], qf0[3]); wb.x = cvt_pk_bf16(kf0[0], kf0[1]); wb.y = cvt_pk_bf16(kf0[2], kf0[3]); store_pair16(QEF + o0, KIF + o0, wa, wb, fq);
                wa.x = cvt_pk_bf16(qf1[0], qf1[1]); wa.y = cvt_pk_bf16(qf1[2], qf1[3]); wb.x = cvt_pk_bf16(kf1[0], kf1[1]); wb.y = cvt_pk_bf16(kf1[2], kf1[3]); store_pair16(QEF + o1, KIF + o1, wa, wb, fq);
                wa.x = cvt_pk_bf16(qb0[0], qb0[1]); wa.y = cvt_pk_bf16(qb0[2], qb0[3]); wb.x = cvt_pk_bf16(kb0[0], kb0[1]); wb.y = cvt_pk_bf16(kb0[2], kb0[3]); store_pair16(QEB + o0, KIB + o0, wa, wb, fq);
                wa.x = cvt_pk_bf16(qb1[0], qb1[1]); wa.y = cvt_pk_bf16(qb1[2], qb1[3]); wb.x = cvt_pk_bf16(kb1[0], kb1[1]); wb.y = cvt_pk_bf16(kb1[2], kb1[3]); store_pair16(QEB + o1, KIB + o1, wa, wb, fq);
                const f32x4 i0 = acc[ai][1][m0][1] * r0, i1 = acc[ai][1][m1][1] * r1;
                wa.x = cvt_pk_bf16(i0[0], i0[1]); wa.y = cvt_pk_bf16(i0[2], i0[3]); wb.x = cvt_pk_bf16(i1[0], i1[1]); wb.y = cvt_pk_bf16(i1[2], i1[3]); store_pair16(VV + o0, VV + o1, wa, wb, fq);
                const size_t oc = (size_t)(lrow0 >> 5) * EI + e0;
                if (fr == 15) *(f32x4*)(DLF + oc) = (f32x4){dlf[0], dlf[1], dlf[2], dlf[3]};
                if (fr == 0) *(f32x4*)(DLB + oc) = (f32x4){dlb[0], dlb[1], dlb[2], dlb[3]};
            }
    }
};

struct EpiSZ {
    const float* rs; int row_base; bf16_t* SZ; RCtx rc;
    __device__ __forceinline__ void operator()(const f32x4 (&acc)[2][2][4][2], const pg8::Unit& u, int wr, int wc, int fr, int fq) const {
            float rz[2][4]; row_rscale8c(rc, rs, row_base + u.pm * 256 + wr * 64 + fr, u.pm, wr * 64 + fr, fq, rz);
            bf16_t* base = SZ + (size_t)(u.pm * 256 + wr * 64 + fr) * EI + u.pn * 256 + wc * 32 + fq * 4;
#pragma unroll
            for (int ai = 0; ai < 2; ++ai)
#pragma unroll
                for (int m = 0; m < 4; ++m)
#pragma unroll
                    for (int bj = 0; bj < 2; ++bj) {
                        u32x2 wn[2];
#pragma unroll
                        for (int n = 0; n < 2; ++n) {
                            const f32x4 z = acc[ai][bj][m][n] * rz[ai][m];
                            const float y0 = z[0] * fast_rcp(1.0f + fast_exp(-z[0])), y1 = z[1] * fast_rcp(1.0f + fast_exp(-z[1]));
                            const float y2 = z[2] * fast_rcp(1.0f + fast_exp(-z[2])), y3 = z[3] * fast_rcp(1.0f + fast_exp(-z[3]));
                            wn[n].x = cvt_pk_bf16(y0, y1); wn[n].y = cvt_pk_bf16(y2, y3);
                        }
                        bf16_t* q = base + (size_t)(ai * 128 + m * 16) * EI + bj * 128;
                        store_pair16(q, q + 16, wn[0], wn[1], fq);
                    }
    }
};

__device__ __forceinline__ int perm_col(int col) {
    const int type = col >> 11, e = col & 2047;
    return (e >> 6) * 256 + (type >> 1) * 128 + ((e >> 4) & 3) * 32 + (type & 1) * 16 + ((e >> 2) & 3) * 4 + (e & 3);
}
struct TileDesc { const float* src; const float* nw; bf16_t* dst; int ld_src, ld_dst, k0, c0, perm_limit; };
struct Params {
    const float* x; const float* norm_w; const float* final_norm_w; const float* conv_w_in; const float* conv_kernel; const float* conv_w_out;
    const float* hgrn_w_in; const float* hgrn_lb; const float* hgrn_norm_w; const float* hgrn_w_out;
    float* out; unsigned char* ws; int never; int pad;
};
__device__ __forceinline__ TileDesc tile_desc(const Params& P, int t) {
    TileDesc d;
    if (t < 4096) { const int l = t >> 11, r = t & 2047, kt = r >> 7, ct = r & 127;
        d.src = P.conv_w_in + (size_t)l * DM * 8192; d.ld_src = 8192; d.k0 = kt * 64; d.c0 = ct * 64; d.nw = P.norm_w + (size_t)(2 * l) * DM; d.dst = (bf16_t*)(P.ws + WS_WCIN) + (size_t)l * 8192 * DM; d.ld_dst = DM; d.perm_limit = 8192;
    } else if (t < 4096 + 5120) { const int q = t - 4096, l = q / 2560, r = q % 2560, kt = r / 160, ct = r % 160;
        d.src = P.hgrn_w_in + (size_t)l * DM * 10240; d.ld_src = 10240; d.k0 = kt * 64; d.c0 = ct * 64; d.nw = P.norm_w + (size_t)(2 * l + 1) * DM; d.dst = (bf16_t*)(P.ws + WS_WHIN) + (size_t)l * 10240 * DM; d.ld_dst = DM; d.perm_limit = 8192;
    } else if (t < 4096 + 5120 + 1024) { const int q = t - 9216, l = q >> 9, r = q & 511, kt = r >> 4, ct = r & 15;
        d.src = P.conv_w_out + (size_t)l * EI * DM; d.ld_src = DM; d.k0 = kt * 64; d.c0 = ct * 64; d.nw = nullptr; d.dst = (bf16_t*)(P.ws + WS_WCOUT) + (size_t)l * DM * EI; d.ld_dst = EI; d.perm_limit = 0;
    } else { const int q = t - 10240, l = q >> 9, r = q & 511, kt = r >> 4, ct = r & 15;
        d.src = P.hgrn_w_out + (size_t)l * EI * DM; d.ld_src = DM; d.k0 = kt * 64; d.c0 = ct * 64; d.nw = nullptr; d.dst = (bf16_t*)(P.ws + WS_WHOUT) + (size_t)l * DM * EI; d.ld_dst = EI; d.perm_limit = 0;
    }
    return d;
}

__device__ __forceinline__ void prologue(const Params& P, LAS unsigned char* lds) {
    LAS float* tiles = (LAS float*)lds;
    const int G = gridDim.x, bid = blockIdx.x, tid = threadIdx.x;
    constexpr int NT = 4096 + 5120 + 1024 + 1024, NG = NT / 4;
    for (int grp = bid; grp < NG; grp += G) {
        f32x4 v[4][2];
        const int rr = tid >> 4, cc = (tid & 15) * 4;
#pragma unroll
        for (int q = 0; q < 4; ++q) { const TileDesc d = tile_desc(P, grp * 4 + q);
#pragma unroll
            for (int p = 0; p < 2; ++p) v[q][p] = *(const f32x4*)(d.src + (size_t)(d.k0 + rr + 32 * p) * d.ld_src + d.c0 + cc); }
#pragma unroll
        for (int q = 0; q < 4; ++q)
#pragma unroll
            for (int p = 0; p < 2; ++p) { LAS float* t = tiles + q * (64 * 65) + (rr + 32 * p) * 65 + cc; t[0] = v[q][p][0]; t[1] = v[q][p][1]; t[2] = v[q][p][2]; t[3] = v[q][p][3]; }
        __syncthreads();
        const int c = tid >> 3, ks = (tid & 7) * 8;
#pragma unroll
        for (int q = 0; q < 4; ++q) { const TileDesc d = tile_desc(P, grp * 4 + q);
            float w8[8];
#pragma unroll
            for (int i = 0; i < 8; ++i) { w8[i] = tiles[q * (64 * 65) + (ks + i) * 65 + c]; if (d.nw) w8[i] *= d.nw[d.k0 + ks + i]; }
            const int col = d.c0 + c, drow = (col < d.perm_limit) ? perm_col(col) : col;
            u32x4 w; w.x = cvt_pk_bf16(w8[0], w8[1]); w.y = cvt_pk_bf16(w8[2], w8[3]); w.z = cvt_pk_bf16(w8[4], w8[5]); w.w = cvt_pk_bf16(w8[6], w8[7]);
            *(u32x4*)(d.dst + (size_t)drow * d.ld_dst + d.k0 + ks) = w; }
        __syncthreads();
    }
    const int lane = tid & 63, gw = bid * 8 + (tid >> 6), nw_ = G * 8;
    bf16_t* xb = (bf16_t*)(P.ws + WS_XB); float* rs = (float*)(P.ws + WS_RS);
    for (int row = gw; row < MT; row += 2 * nw_) {
        f32x4 v[2][4];
#pragma unroll
        for (int q = 0; q < 2; ++q)
#pragma unroll
            for (int i = 0; i < 4; ++i) v[q][i] = *(const f32x4*)(P.x + (size_t)(row + q * nw_) * DM + i * 256 + lane * 4);
#pragma unroll
        for (int q = 0; q < 2; ++q) {
            float ss = 0.f;
#pragma unroll
            for (int i = 0; i < 4; ++i) {
                const f32x4 a = v[q][i];
                ss += (a[0] * a[0] + a[1] * a[1]) + (a[2] * a[2] + a[3] * a[3]);
                u32x2 w; w.x = cvt_pk_bf16(a[0], a[1]); w.y = cvt_pk_bf16(a[2], a[3]); *(u32x2*)(xb + (size_t)(row + q * nw_) * DM + i * 256 + lane * 4) = w;
            }
#pragma unroll
            for (int o = 32; o >= 1; o >>= 1) ss += __shfl_xor(ss, o);
            if (lane < 16) rs[(size_t)lane * MT + row + q * nw_] = lane == 0 ? ss : 0.f;
        }
    }
}

__device__ __forceinline__ void conv_fix(bf16_t* Y, bf16_t* Yhi, const bf16_t* __restrict__ VE, const bf16_t* __restrict__ GE, const float* __restrict__ ck  ) {
    const int nthreads = gridDim.x * 512; constexpr int NBLK = MT / 64;
    for (int task = blockIdx.x * 512 + threadIdx.x; task < (NBLK + 1) * 256; task += nthreads) {
        const int ec = task & 255, B = task >> 8, e0 = ec * 8, t = 64 * B;
        const bool seqb = (t & (SEQ - 1)) == 0, hasp = B > 0, hasn = B < NBLK;
        const u32x4 zero = (u32x4){0u, 0u, 0u, 0u};
        u32x4 va = zero, vb = zero, gb = zero, vc = zero, vd = zero, gc = zero;
        if (hasp) { va = *(const u32x4*)(VE + ((size_t)(B - 1) * 4 + 0) * EI + e0); vb = *(const u32x4*)(VE + ((size_t)(B - 1) * 4 + 1) * EI + e0); gb = *(const u32x4*)(GE + ((size_t)(B - 1) * 2 + 0) * EI + e0); }
        if (hasn) { vc = *(const u32x4*)(VE + ((size_t)B * 4 + 2) * EI + e0); vd = *(const u32x4*)(VE + ((size_t)B * 4 + 3) * EI + e0); gc = *(const u32x4*)(GE + ((size_t)B * 2 + 1) * EI + e0); }
        float k0[8], k1[8], k2[8];
#pragma unroll
        for (int i = 0; i < 8; ++i) { k0[i] = ck[e0 + i]; k1[i] = ck[EI + e0 + i]; k2[i] = ck[2 * EI + e0 + i]; }
        const u32x4 vcn = seqb ? zero : vc, vbp = seqb ? zero : vb;
        float y1[8], y2[8];
#pragma unroll
        for (int h = 0; h < 4; ++h) {
            y1[2 * h] = bflo(gb[h]) * (k0[2 * h] * bflo(va[h]) + k1[2 * h] * bflo(vb[h]) + k2[2 * h] * bflo(vcn[h]));
            y1[2 * h + 1] = bfhi(gb[h]) * (k0[2 * h + 1] * bfhi(va[h]) + k1[2 * h + 1] * bfhi(vb[h]) + k2[2 * h + 1] * bfhi(vcn[h]));
            y2[2 * h] = bflo(gc[h]) * (k0[2 * h] * bflo(vbp[h]) + k1[2 * h] * bflo(vc[h]) + k2[2 * h] * bflo(vd[h]));
            y2[2 * h + 1] = bfhi(gc[h]) * (k0[2 * h + 1] * bfhi(vbp[h]) + k1[2 * h + 1] * bfhi(vc[h]) + k2[2 * h + 1] * bfhi(vd[h]));
        }
        if (hasp) { u32x4 w; w.x = cvt_pk_bf16(y1[0], y1[1]); w.y = cvt_pk_bf16(y1[2], y1[3]); w.z = cvt_pk_bf16(y1[4], y1[5]); w.w = cvt_pk_bf16(y1[6], y1[7]); *(u32x4*)(((t - 1 >= MH) ? Yhi : Y) + (size_t)(t - 1) * EI + e0) = w; }
        if (hasn) { u32x4 w; w.x = cvt_pk_bf16(y2[0], y2[1]); w.y = cvt_pk_bf16(y2[2], y2[3]); w.z = cvt_pk_bf16(y2[4], y2[5]); w.w = cvt_pk_bf16(y2[6], y2[7]); *(u32x4*)(((t >= MH) ? Yhi : Y) + (size_t)t * EI + e0) = w; }
    }
}

__device__ __forceinline__ unsigned offb(unsigned row, unsigned ch) { return 256u * row + 16u * (ch ^ (((row & 3u) << 2) | ((row >> 2) & 3u))); }
constexpr int SCAN_BUF = 8192 + 8192 + 8192 + 512;
constexpr int SCAN_XCH = 2 * SCAN_BUF;
__device__ __forceinline__ bf16x8 pack8(const f32x4 a, const f32x4 b) {
    u32x4 w; w.x = cvt_pk_bf16(a[0], a[1]); w.y = cvt_pk_bf16(a[2], a[3]); w.z = cvt_pk_bf16(b[0], b[1]); w.w = cvt_pk_bf16(b[2], b[3]);
    return __builtin_bit_cast(bf16x8, w);
}
__device__ __forceinline__ bf16x8 join8(u32x2 lo, u32x2 hi) { u32x4 w; w.x = lo.x; w.y = lo.y; w.z = hi.x; w.w = hi.y; return __builtin_bit_cast(bf16x8, w); }

__device__ __forceinline__ void scan_phase(LAS unsigned char* lds, bf16_t* QEF, const bf16_t* __restrict__ KIF, bf16_t* QEB, const bf16_t* __restrict__ KIB,
                                           const bf16_t* __restrict__ VV, const float* __restrict__ DLF, const float* __restrict__ DLB) {
    int tid = threadIdx.x; asm volatile("" : "+v"(tid));
    const int lane = tid & 63, w = __builtin_amdgcn_readfirstlane(tid >> 6), c = lane & 15, g = lane >> 4, kh = w >> 2, vq = w & 3;
    const unsigned lbase = (unsigned)(unsigned long long)lds;
    for (int item = blockIdx.x; item < 128; item += gridDim.x) {
        const int dir = item & 1, h = (item >> 1) & 15, b = item >> 5;
        bf16_t* QE = dir ? QEB : QEF; const bf16_t* KI = dir ? KIB : KIF; const float* DL = dir ? DLB : DLF;
        const int lrow = tid >> 4, lch = tid & 15;
        const size_t hbase = (size_t)b * ((size_t)EI * SEQ) + (size_t)h * ((size_t)SEQ * 128);
        const bf16_t* qk_src = ((lch < 8) ? (const bf16_t*)QE : KI) + hbase + (size_t)lrow * 128 + (lch & 7) * 8;
        const bf16_t* v_src = VV + hbase + (size_t)lrow * 128 + lch * 8;
        const float* dl_src = DL + (size_t)(b * (SEQ / 32)) * EI + h * 128 + (tid & 127);
        const unsigned st_qk = offb(lrow, lch), st_v = 16384u + offb(lrow, lch);
        const unsigned rq = (unsigned)(g >> 1);
        const unsigned rrow = (unsigned)c;
        const unsigned swz = ((rrow & 3u) << 2) | ((rrow >> 2) & 3u);
        const unsigned rowb = (unsigned)kh * 8192u + 256u * rrow + (unsigned)(g & 1) * 8u;
        const unsigned trow = 4u * (unsigned)g + ((unsigned)c >> 2), tp = (unsigned)c & 3u;
        const unsigned tr_v0 = 16384u + offb(trow, 2u * (unsigned)(2 * vq) + (tp >> 1)) + 8u * (tp & 1u);
        const unsigned tr_v1 = 16384u + offb(trow, 2u * (unsigned)(2 * vq + 1) + (tp >> 1)) + 8u * (tp & 1u);
        unsigned tr_k[4];
#pragma unroll
        for (int kt = 0; kt < 4; ++kt) tr_k[kt] = (unsigned)kh * 8192u + offb(trow, 2u * (unsigned)(4 + kt) + (tp >> 1)) + 8u * (tp & 1u);
        bf16_t* o_dst = QE + hbase + (size_t)c * 128 + vq * 32 + g * 4;
        const unsigned xchw = (unsigned)SCAN_XCH + (unsigned)kh * 16384u + (unsigned)vq * 4096u + (unsigned)lane * 16u;
        const unsigned xchr = (unsigned)SCAN_XCH + (unsigned)vq * 4096u + (unsigned)(kh * 2) * 1024u + (unsigned)lane * 16u;
        const unsigned dlo = 24576u + (unsigned)(kh * 64 + 4 * g) * 4u;

        f32x4 S[2][4];
#pragma unroll
        for (int vt = 0; vt < 2; ++vt) {
#pragma unroll
            for (int kt = 0; kt < 4; ++kt) S[vt][kt] = (f32x4){0.f, 0.f, 0.f, 0.f};
        }
#define SCAN_CI(s_) (dir ? 127 - ((s_) < 127 ? (s_) : 127) : ((s_) < 127 ? (s_) : 127))
#define SCAN_LOAD(cn_, P0, P1, PV, PD) do { P0 = *(const u32x4*)(qk_src + (size_t)(cn_) * 32 * 128); P1 = *(const u32x4*)(qk_src + (size_t)(cn_) * 32 * 128 + 64); \
            PV = *(const u32x4*)(v_src + (size_t)(cn_) * 32 * 128); if (tid < 128) PD = dl_src[(size_t)(cn_) * EI]; } while (0)
#define SCAN_PUT(bn_, P0, P1, PV, PD) do { *(LAS u32x4*)(lds + (bn_) + st_qk) = P0; *(LAS u32x4*)(lds + (bn_) + 8192u + st_qk) = P1; \
            *(LAS u32x4*)(lds + (bn_) + st_v) = PV; if (tid < 128) *(LAS float*)(lds + (bn_) + 24576u + tid * 4) = PD; } while (0)
        const u32x4 z4 = (u32x4){0u, 0u, 0u, 0u};
        u32x4 p0A = z4, p1A = z4, pvA = z4, p0B = z4, p1B = z4, pvB = z4, p0C = z4, p1C = z4, pvC = z4, p0D = z4, p1D = z4, pvD = z4; float pdA = 0.f, pdB = 0.f, pdC = 0.f, pdD = 0.f;
        {
            SCAN_LOAD(SCAN_CI(0), p0A, p1A, pvA, pdA); SCAN_LOAD(SCAN_CI(1), p0B, p1B, pvB, pdB); SCAN_LOAD(SCAN_CI(2), p0C, p1C, pvC, pdC); SCAN_LOAD(SCAN_CI(3), p0D, p1D, pvD, pdD);
            SCAN_PUT(0u, p0A, p1A, pvA, pdA);
        }
        __syncthreads();
#define SCAN_FLUSH(s_) do { const int cp = SCAN_CI((s_) - 1); const unsigned xo = xchr + (unsigned)(((s_) - 1) & 1) * 32768u; u32x2 wv[2]; \
            _Pragma("unroll") for (int pt = 0; pt < 2; ++pt) { const f32x4 o = *(const LAS f32x4*)(lds + xo + pt * 1024) + *(const LAS f32x4*)(lds + xo + 16384u + pt * 1024); \
                wv[pt].x = cvt_pk_bf16(o[0], o[1]); wv[pt].y = cvt_pk_bf16(o[2], o[3]); } \
            store_pair16(o_dst + (size_t)(cp * 32) * 128 + kh * 16, o_dst + (size_t)(cp * 32 + 16) * 128 + kh * 16, wv[0], wv[1], g); } while (0)
#define SCAN_STEP(s_, BO, BN, P0W, P1W, PVW, PDW, P0L, P1L, PVL, PDL) do { \
            const unsigned bo = (BO), bn = (BN); \
            SCAN_LOAD(SCAN_CI((s_) + 4), P0L, P1L, PVL, PDL); \
            bf16x8 qeB[2][2], kiA[2][2]; \
            _Pragma("unroll") for (int kk = 0; kk < 2; ++kk) { \
                const unsigned ch0 = (unsigned)(4 * kk) | rq, ch1 = ch0 | 2u; \
                const unsigned a0 = bo + rowb + 16u * (ch0 ^ swz), a1 = bo + rowb + 16u * (ch1 ^ swz); \
                const unsigned k0 = bo + rowb + 16u * ((ch0 | 8u) ^ swz), k1 = bo + rowb + 16u * ((ch1 | 8u) ^ swz); \
                _Pragma("unroll") for (int pt = 0; pt < 2; ++pt) { \
                    qeB[pt][kk] = join8(*(const LAS u32x2*)(lds + a0 + pt * 4096), *(const LAS u32x2*)(lds + a1 + pt * 4096)); \
                    kiA[pt][kk] = join8(*(const LAS u32x2*)(lds + k0 + pt * 4096), *(const LAS u32x2*)(lds + k1 + pt * 4096)); } } \
            u32x2 vlo[2], vhi[2], klo[4], khi[4]; \
            { const unsigned av0 = lbase + bo + tr_v0, av1 = lbase + bo + tr_v1, ak0 = lbase + bo + tr_k[0], ak1 = lbase + bo + tr_k[1], ak2 = lbase + bo + tr_k[2], ak3 = lbase + bo + tr_k[3]; \
              asm volatile("ds_read_b64_tr_b16 %0, %12\n\tds_read_b64_tr_b16 %1, %12 offset:4096\n\t" \
                           "ds_read_b64_tr_b16 %2, %13\n\tds_read_b64_tr_b16 %3, %13 offset:4096\n\t" \
                           "ds_read_b64_tr_b16 %4, %14\n\tds_read_b64_tr_b16 %5, %14 offset:4096\n\t" \
                           "ds_read_b64_tr_b16 %6, %15\n\tds_read_b64_tr_b16 %7, %15 offset:4096\n\t" \
                           "ds_read_b64_tr_b16 %8, %16\n\tds_read_b64_tr_b16 %9, %16 offset:4096\n\t" \
                           "ds_read_b64_tr_b16 %10, %17\n\tds_read_b64_tr_b16 %11, %17 offset:4096\n\t" \
                           "s_waitcnt lgkmcnt(0)" \
                           : "=&v"(vlo[0]), "=&v"(vhi[0]), "=&v"(vlo[1]), "=&v"(vhi[1]), "=&v"(klo[0]), "=&v"(khi[0]), "=&v"(klo[1]), "=&v"(khi[1]), "=&v"(klo[2]), "=&v"(khi[2]), "=&v"(klo[3]), "=&v"(khi[3]) \
                           : "v"(av0), "v"(av1), "v"(ak0), "v"(ak1), "v"(ak2), "v"(ak3) : "memory"); } \
            bf16x8 ATp[2]; \
            { f32x4 AT[2][2]; \
              _Pragma("unroll") for (int ut = 0; ut < 2; ++ut) _Pragma("unroll") for (int pt = 0; pt < 2; ++pt) { \
                f32x4 z = (f32x4){0.f, 0.f, 0.f, 0.f}; \
                z = __builtin_amdgcn_mfma_f32_16x16x32_bf16(kiA[ut][0], qeB[pt][0], z, 0, 0, 0); \
                z = __builtin_amdgcn_mfma_f32_16x16x32_bf16(kiA[ut][1], qeB[pt][1], z, 0, 0, 0); \
                _Pragma("unroll") for (int i = 0; i < 4; ++i) { const int uu = 16 * ut + 4 * g + i, pp = 16 * pt + c; const bool keep = dir ? (uu >= pp) : (uu <= pp); z[i] = keep ? z[i] : 0.f; } \
                AT[ut][pt] = z; } \
              ATp[0] = pack8(AT[0][0], AT[1][0]); ATp[1] = pack8(AT[0][1], AT[1][1]); } \
            _Pragma("unroll") for (int vt = 0; vt < 2; ++vt) { \
                const bf16x8 vT = join8(vlo[vt], vhi[vt]); \
                const bf16x8 Sf0 = pack8(S[vt][0], S[vt][1]), Sf1 = pack8(S[vt][2], S[vt][3]); \
                _Pragma("unroll") for (int pt = 0; pt < 2; ++pt) { \
                    f32x4 o = (f32x4){0.f, 0.f, 0.f, 0.f}; \
                    o = __builtin_amdgcn_mfma_f32_16x16x32_bf16(Sf0, qeB[pt][0], o, 0, 0, 0); \
                    o = __builtin_amdgcn_mfma_f32_16x16x32_bf16(Sf1, qeB[pt][1], o, 0, 0, 0); \
                    o = __builtin_amdgcn_mfma_f32_16x16x32_bf16(vT, ATp[pt], o, 0, 0, 0); \
                    *(LAS f32x4*)(lds + xchw + (unsigned)((s_) & 1) * 32768u + (vt * 2 + pt) * 1024) = o; } \
                _Pragma("unroll") for (int kt = 0; kt < 4; ++kt) { \
                    S[vt][kt] = __builtin_amdgcn_mfma_f32_16x16x32_bf16(join8(klo[kt], khi[kt]), vT, S[vt][kt], 0, 0, 0); \
                    S[vt][kt] = S[vt][kt] * *(const LAS f32x4*)(lds + bo + dlo + 64 * kt); } } \
            if ((s_) > 0) SCAN_FLUSH(s_);     \
            SCAN_PUT(bn, P0W, P1W, PVW, PDW); \
            __syncthreads(); } while (0)
        for (int s = 0; s < 128; s += 4) {
            SCAN_STEP(s, 0u, (unsigned)SCAN_BUF, p0B, p1B, pvB, pdB, p0A, p1A, pvA, pdA);
            SCAN_STEP(s + 1, (unsigned)SCAN_BUF, 0u, p0C, p1C, pvC, pdC, p0B, p1B, pvB, pdB);
            SCAN_STEP(s + 2, 0u, (unsigned)SCAN_BUF, p0D, p1D, pvD, pdD, p0C, p1C, pvC, pdC);
            SCAN_STEP(s + 3, (unsigned)SCAN_BUF, 0u, p0A, p1A, pvA, pdA, p0D, p1D, pvD, pdD);
        }
        SCAN_FLUSH(128);
        __syncthreads();
#undef SCAN_STEP
#undef SCAN_FLUSH
#undef SCAN_PUT
#undef SCAN_LOAD
#undef SCAN_CI
    }
}

__device__ __forceinline__ void combine_phase(const bf16_t* __restrict__ OF, const bf16_t* __restrict__ OB, const bf16_t* __restrict__ SZ, bf16_t* __restrict__ ON, const float* __restrict__ nw) {
    const int nthreads = gridDim.x * 512;
    for (int task0 = blockIdx.x * 512 + threadIdx.x; task0 < MH * 256; task0 += 2 * nthreads) {
        u32x4 a0[2], b0[2], zz[2];
#pragma unroll
        for (int q = 0; q < 2; ++q) {
            const int task = task0 + q * nthreads; const int cv = task & 15, tin = (task >> 4) & (SEQ - 1), hh = (task >> 16) & 15, bb = task >> 20;
            const size_t off = (size_t)bb * ((size_t)EI * SEQ) + (size_t)hh * ((size_t)SEQ * 128) + (size_t)tin * 128 + cv * 8;
            a0[q] = *(const u32x4*)(OF + off); b0[q] = *(const u32x4*)(OB + off);
            zz[q] = *(const u32x4*)(SZ + (size_t)(bb * SEQ + tin) * EI + hh * 128 + cv * 8);
        }
#pragma unroll
        for (int q = 0; q < 2; ++q) {
            const int task = task0 + q * nthreads; const int cv = task & 15, tin = (task >> 4) & (SEQ - 1), hh = (task >> 16) & 15, bb = task >> 20, t = bb * SEQ + tin;
            float o[8]; float ss = 0.f;
#pragma unroll
            for (int i = 0; i < 4; ++i) {
                o[2 * i] = bflo(a0[q][i]) + bflo(b0[q][i]);
                o[2 * i + 1] = bfhi(a0[q][i]) + bfhi(b0[q][i]);
                ss += o[2 * i] * o[2 * i] + o[2 * i + 1] * o[2 * i + 1];
            }
            ss += __shfl_xor(ss, 1); ss += __shfl_xor(ss, 2); ss += __shfl_xor(ss, 4); ss += __shfl_xor(ss, 8);
            const float r = rsqrtf(ss * (1.0f / 128.0f) + EPSV);
            const int e = hh * 128 + cv * 8;
            const f32x4 w0 = *(const f32x4*)(nw + e), w1 = *(const f32x4*)(nw + e + 4);
            u32x4 w; w.x = cvt_pk_bf16(o[0] * r * w0[0] * bflo(zz[q].x), o[1] * r * w0[1] * bfhi(zz[q].x)); w.y = cvt_pk_bf16(o[2] * r * w0[2] * bflo(zz[q].y), o[3] * r * w0[3] * bfhi(zz[q].y));
            w.z = cvt_pk_bf16(o[4] * r * w1[0] * bflo(zz[q].z), o[5] * r * w1[1] * bfhi(zz[q].z)); w.w = cvt_pk_bf16(o[6] * r * w1[2] * bflo(zz[q].w), o[7] * r * w1[3] * bfhi(zz[q].w));
            *(u32x4*)(ON + (size_t)t * EI + e) = w;
        }
    }
}

__device__ __forceinline__ void final_norm(const bf16_t* __restrict__ xb, float* __restrict__ out, const float* __restrict__ fw) {
    const int lane = threadIdx.x & 63, gw = blockIdx.x * 8 + (threadIdx.x >> 6), nw_ = gridDim.x * 8;
    f32x4 wv[4];
#pragma unroll
    for (int i = 0; i < 4; ++i) wv[i] = *(const f32x4*)(fw + i * 256 + lane * 4);
    for (int row = gw; row < MT; row += 2 * nw_) {
        u32x2 v[2][4];
#pragma unroll
        for (int q = 0; q < 2; ++q)
#pragma unroll
            for (int i = 0; i < 4; ++i) v[q][i] = *(const u32x2*)(xb + (size_t)(row + q * nw_) * DM + i * 256 + lane * 4);
#pragma unroll
        for (int q = 0; q < 2; ++q) {
            f32x4 f[4]; float ss = 0.f;
#pragma unroll
            for (int i = 0; i < 4; ++i) { f[i] = (f32x4){bflo(v[q][i].x), bfhi(v[q][i].x), bflo(v[q][i].y), bfhi(v[q][i].y)}; ss += (f[i][0] * f[i][0] + f[i][1] * f[i][1]) + (f[i][2] * f[i][2] + f[i][3] * f[i][3]); }
#pragma unroll
            for (int o = 32; o >= 1; o >>= 1) ss += __shfl_xor(ss, o);
            const float r = rsqrtf(ss * (1.0f / DM) + EPSV);
#pragma unroll
            for (int i = 0; i < 4; ++i) *(f32x4*)(out + (size_t)(row + q * nw_) * DM + i * 256 + lane * 4) = f[i] * r * wv[i];
        }
    }
}


#define XB_TMO      128
#define XB_XCNT(j)  (256  + 64 * (j))
#define XB_XSUB(j)  (1280 + 64 * (j))
#define XB_XGEN(j)  (2304 + 64 * (j))
#define XB_TOP      3328
#define XB_TOPGEN   3392
#define XCD_BAR_WORDS 3456
#define XB_SPIN_CAP (1u << 18)
__device__ __forceinline__ unsigned xb_ld(unsigned* p)              { return __hip_atomic_load(p, __ATOMIC_RELAXED, __HIP_MEMORY_SCOPE_AGENT); }
__device__ __forceinline__ unsigned xb_add(unsigned* p, unsigned v) { return __hip_atomic_fetch_add(p, v, __ATOMIC_RELAXED, __HIP_MEMORY_SCOPE_AGENT); }
__device__ __forceinline__ unsigned xb_xcc_id() { return (unsigned)__builtin_amdgcn_s_getreg((3 << 11) | 20) & 0xFu; }
#define XB_SPIN(cond, bar) do { unsigned _sp = 0; while (cond) { __builtin_amdgcn_s_sleep(1); \
    if ((++_sp & 255u) == 0u) { if (xb_ld(&(bar)[XB_TMO])) break; if (_sp > XB_SPIN_CAP) { atomicAdd(&(bar)[XB_TMO], 1u); break; } } } } while (0)
struct XcdBarrier { unsigned* bar; unsigned x; volatile LAS unsigned* st; };
__device__ __forceinline__ XcdBarrier xcd_barrier_post(unsigned* bar, volatile LAS unsigned* st) {
    XcdBarrier b; b.bar = bar; b.x = xb_xcc_id(); b.st = st;
    if (threadIdx.x == 0) (void)xb_add(&bar[XB_XCNT(b.x)], 1u);
    return b;
}
__device__ __forceinline__ void xcd_barrier_complete(unsigned* bar, unsigned x, unsigned& nloc, unsigned& nx) {
    const unsigned G = gridDim.x * gridDim.y * gridDim.z;
    unsigned sum, cnt, mine, sp = 0u;
    for (;;) {
        sum = 0u; cnt = 0u; mine = 0u;
#pragma unroll
        for (unsigned j = 0; j < 16; ++j) { const unsigned c = xb_ld(&bar[XB_XCNT(j)]); sum += c; cnt += (c > 0u) ? 1u : 0u; mine = (j == x) ? c : mine; }
        if (sum == G) break;
        __builtin_amdgcn_s_sleep(1);
        if ((++sp & 255u) == 0u) { if (xb_ld(&bar[XB_TMO])) break; if (sp > XB_SPIN_CAP) { atomicAdd(&bar[XB_TMO], 1u); break; } }
    }
    nloc = mine > 0u ? mine : 1u; nx = cnt > 0u ? cnt : 1u;
}
__device__ __forceinline__ void xcd_barrier(const XcdBarrier& b) {
    asm volatile("s_waitcnt vmcnt(0)" ::: "memory");
    __syncthreads();
    if (threadIdx.x == 0) {
        unsigned* bar = b.bar;
        __builtin_amdgcn_s_waitcnt(0);
        unsigned nloc = b.st[0], nx = b.st[1];
        if (nloc == 0u) { xcd_barrier_complete(bar, b.x, nloc, nx); b.st[0] = nloc; b.st[1] = nx; }
        const unsigned old = xb_add(&bar[XB_XSUB(b.x)], 1u);
        const unsigned gen = old / nloc;
        if (old + 1u == (gen + 1u) * nloc) {
            __builtin_amdgcn_fence(__ATOMIC_RELEASE, "agent");
            asm volatile("s_waitcnt vmcnt(0)" ::: "memory");
            const unsigned og = xb_add(&bar[XB_TOP], 1u);
            const unsigned tg = og / nx;
            if (og + 1u == (tg + 1u) * nx) xb_add(&bar[XB_TOPGEN], 1u);
            else XB_SPIN(xb_ld(&bar[XB_TOPGEN]) == tg, bar);
            __builtin_amdgcn_fence(__ATOMIC_ACQUIRE, "agent");
            xb_add(&bar[XB_XGEN(b.x)], 1u);
            asm volatile("s_waitcnt vmcnt(0)" ::: "memory");
        } else {
            XB_SPIN(xb_ld(&bar[XB_XGEN(b.x)]) == gen, bar);
            __builtin_amdgcn_fence(__ATOMIC_ACQUIRE, "agent");
            asm volatile("s_waitcnt vmcnt(0)" ::: "memory");
        }
    }
    __syncthreads();
}

__device__ __forceinline__ void grid_barrier(cg::grid_group& grid) {
    asm volatile("s_waitcnt vmcnt(0) lgkmcnt(0)" ::: "memory");
    grid.sync();
    __builtin_amdgcn_fence(__ATOMIC_ACQUIRE, "agent");
    asm volatile("s_waitcnt vmcnt(0)" ::: "memory");
}
__global__ void __launch_bounds__(512, 2) fwd_megakernel(Params P) {
    extern __shared__ __attribute__((aligned(16))) unsigned char lds_raw[];
    LAS unsigned char* lds = (LAS unsigned char*)lds_raw;
    cg::grid_group grid = cg::this_grid();
    const int G = gridDim.x, bid = blockIdx.x;
    unsigned char* ws = P.ws;
    bf16_t* xb = (bf16_t*)(ws + WS_XB); float* rs = (float*)(ws + WS_RS);

    volatile LAS unsigned* xbst = (volatile LAS unsigned*)(lds + pg8::STAGE_BYTES);
    if (threadIdx.x == 0) { xbst[0] = 0u; xbst[1] = 0u; xbst[2] = 0u; xbst[3] = 0u; }
    __syncthreads();
    const XcdBarrier xbar = xcd_barrier_post((unsigned*)(ws + WS_BAR), xbst);
    prologue(P, lds);
    if (P.never) grid_barrier(grid);
    xcd_barrier(xbar);

#pragma nounroll
    for (int layer = 0; layer < DBG_LAYERS; ++layer) {
        const int j = layer >> 1;
        if ((layer & 1) == 0) {
            bf16_t* VE = (bf16_t*)(ws + WS_CV); bf16_t* GE = (bf16_t*)(ws + WS_CV + 16 * MiB); bf16_t* Gb = (bf16_t*)(ws + WS_CG);
            {
                pg8::Gemm g{xb, (const bf16_t*)(ws + WS_WCIN) + (size_t)j * 8192 * DM, MT, 8192, DM}; pg8::StaticOrder S; S.init(MT, 8192, G, bid);
                const RCtx rc = fill_row_scales(lds, S, rs, 0);
                EpiConv1 E{rs, Gb, VE, GE, P.conv_kernel + (size_t)j * 3 * EI, rc, (bf16_t*)P.out};
                pg8::gemm_phase<EpiConv1>(lds, g, S, E);
            }
            xcd_barrier(xbar);
            conv_fix(Gb, (bf16_t*)P.out, VE, GE, P.conv_kernel + (size_t)j * 3 * EI);
            xcd_barrier(xbar);
            {
                pg8::Gemm g{Gb, (const bf16_t*)(ws + WS_WCOUT) + (size_t)j * DM * EI, MH, DM, EI}; pg8::StaticOrder S; S.init(MH, DM, G, bid);
                EpiRes E{xb, rs, 0};
                pg8::gemm_phase<EpiRes>(lds, g, S, E);
            }
            xcd_barrier(xbar);
        } else {
            bf16_t* QEF = (bf16_t*)(ws + WS_QEF); bf16_t* KIF = (bf16_t*)(ws + WS_KIF); bf16_t* QEB = (bf16_t*)(ws + WS_QEB); bf16_t* KIB = (bf16_t*)(ws + WS_KIB); bf16_t* VV = (bf16_t*)(ws + WS_VV);
            float* DLF = (float*)(ws + WS_DLF); float* DLB = (float*)(ws + WS_DLB);
            bf16_t* Y0 = (bf16_t*)P.out + (size_t)MH * EI;
            const bf16_t* Win = (const bf16_t*)(ws + WS_WHIN) + (size_t)j * 10240 * DM;
#pragma nounroll
            for (int half = 0; half < 2; ++half) {
                const int rb = half * MH;
                {
                    pg8::Gemm g{xb + (size_t)rb * DM, Win, MH, 8192, DM}; pg8::StaticOrder S; S.init(MH, 8192, G, bid);
                    const RCtx rc = fill_row_scales(lds, S, rs, rb);
                    EpiH1 E{rs, P.hgrn_lb, j, rb, QEF, KIF, QEB, KIB, VV, DLF, DLB, (bf16_t*)P.out, rc};
                    pg8::gemm_phase<EpiH1>(lds, g, S, E);
                }
                xcd_barrier(xbar);
                if (bid < 128 || G < 256) {
                    scan_phase(lds, QEF, KIF, QEB, KIB, VV, DLF, DLB);
                }
                if (bid >= 128 || G < 256) {
                    const int Gz = (G < 256) ? G : G - 128, cz = (G < 256) ? bid : bid - 128;
                    pg8::Gemm g{xb + (size_t)rb * DM, Win + (size_t)8192 * DM, MH, EI, DM}; pg8::StaticOrder S; S.init(MH, EI, Gz, cz, (G < 256) ? 8 : 4);
                    const RCtx rc = fill_row_scales(lds, S, rs, rb);
                    EpiSZ E{rs, rb, (bf16_t*)P.out, rc};
                    pg8::gemm_phase<EpiSZ>(lds, g, S, E);
                    if (half == 0) {
                        pg8::Gemm g2{(const bf16_t*)P.out + (size_t)MH * EI, (const bf16_t*)(ws + WS_WCOUT) + (size_t)j * DM * EI, MH, DM, EI}; pg8::StaticOrder S2; S2.init(MH, DM, Gz, cz, (G < 256) ? 8 : 4);
                        EpiRes E2{xb, rs, MH};
                        pg8::gemm_phase<EpiRes>(lds, g2, S2, E2);
                    }
                    if (half == 1) {
                        pg8::Gemm g2{Y0, (const bf16_t*)(ws + WS_WHOUT) + (size_t)j * DM * EI, MH, DM, EI}; pg8::StaticOrder S2; S2.init(MH, DM, Gz, cz, (G < 256) ? 8 : 4);
                        EpiRes E2{xb, rs, 0};
                        pg8::gemm_phase<EpiRes>(lds, g2, S2, E2);
                    }
                }
                xcd_barrier(xbar);
                combine_phase(QEF, QEB, (const bf16_t*)P.out, (half == 0) ? Y0 : VV, P.hgrn_norm_w + (size_t)j * EI);
                xcd_barrier(xbar);
                if (half == 1) {
                    pg8::Gemm g{VV, (const bf16_t*)(ws + WS_WHOUT) + (size_t)j * DM * EI, MH, DM, EI}; pg8::StaticOrder S; S.init(MH, DM, G, bid);
                    EpiRes E{xb, rs, rb};
                    pg8::gemm_phase<EpiRes>(lds, g, S, E);
                    xcd_barrier(xbar);
                }
            }
        }
    }
    if (DBG_LAYERS == 0) { const size_t n = (size_t)MT * DM; for (size_t i = (size_t)blockIdx.x * 512 + threadIdx.x; i < n; i += (size_t)gridDim.x * 512) P.out[i] = P.x[i]; xcd_barrier(xbar); }
    final_norm(xb, P.out, P.final_norm_w);
}

extern "C" void kernel_launch(void* const* d_in, const int* in_sizes, int n_in, void* d_out, int out_size, void* d_ws, size_t ws_size, hipStream_t stream) {
    constexpr size_t kDynLds = pg8::STAGE_BYTES + 16 + 2048;
    static int grid_blocks = 0;
    if (!grid_blocks) {
        if (ws_size < WS_END) { fprintf(stderr, "kernel_launch: workspace too small: %zu < %zu\n", ws_size, (size_t)WS_END); grid_blocks = -1; return; }
        int dev = 0, cus = 0, per_cu = 0;
        hipGetDevice(&dev);
        hipDeviceGetAttribute(&cus, hipDeviceAttributeMultiprocessorCount, dev);
        if (hipFuncSetAttribute((const void*)fwd_megakernel, hipFuncAttributeMaxDynamicSharedMemorySize, (int)kDynLds) != hipSuccess) { fprintf(stderr, "kernel_launch: hipFuncSetAttribute failed\n"); grid_blocks = -1; return; }
        hipOccupancyMaxActiveBlocksPerMultiprocessor(&per_cu, (const void*)fwd_megakernel, 512, kDynLds);
        if (per_cu < 1) per_cu = 1;
        grid_blocks = cus * per_cu;
        if (grid_blocks > 256) grid_blocks = 256;
        (void)hipGetLastError();
    }
    if (grid_blocks < 0) return;
    if (hipMemsetAsync((char*)d_ws + WS_BAR, 0, 16384, stream) != hipSuccess) { fprintf(stderr, "kernel_launch: memset of barrier words failed\n"); return; }
    Params p{};
    p.x = (const float*)d_in[0]; p.norm_w = (const float*)d_in[1]; p.final_norm_w = (const float*)d_in[2]; p.conv_w_in = (const float*)d_in[3]; p.conv_kernel = (const float*)d_in[4];
    p.conv_w_out = (const float*)d_in[5]; p.hgrn_w_in = (const float*)d_in[6]; p.hgrn_lb = (const float*)d_in[7]; p.hgrn_norm_w = (const float*)d_in[8]; p.hgrn_w_out = (const float*)d_in[9];
    p.out = (float*)d_out; p.ws = (unsigned char*)d_ws;
    void* args[] = {&p};
    hipError_t e = hipLaunchCooperativeKernel((void*)fwd_megakernel, dim3(grid_blocks), dim3(512), args, kDynLds, stream);
    if (e != hipSuccess) fprintf(stderr, "cooperative launch failed: %s (grid %d)\n", hipGetErrorString(e), grid_blocks);
}
```

```cpp
#include <hip/hip_runtime.h>
#include <hip/hip_cooperative_groups.h>
#include <cstdio>
namespace cg = cooperative_groups;
#ifndef DBG_LAYERS
#define DBG_LAYERS 4
#endif

#define LAS __attribute__((address_space(3)))
typedef unsigned short bf16_t;
typedef short bf16x8 __attribute__((ext_vector_type(8)));
typedef short bf16x4 __attribute__((ext_vector_type(4)));
typedef float f32x4 __attribute__((ext_vector_type(4)));
typedef unsigned u32x4 __attribute__((ext_vector_type(4)));
typedef unsigned u32x2 __attribute__((ext_vector_type(2)));

constexpr int DM = 1024, EI = 2048, SEQ = 4096, NB = 8, MT = NB * SEQ  , MH = MT / 2;
constexpr float EPSV = 1e-6f;
constexpr size_t MiB = 1024ull * 1024ull;
constexpr size_t WS_XB = 0;
constexpr size_t WS_WCIN = WS_XB + 64 * MiB;
constexpr size_t WS_WCOUT = WS_WCIN + 32 * MiB;
constexpr size_t WS_WHIN = WS_WCOUT + 8 * MiB;
constexpr size_t WS_WHOUT = WS_WHIN + 40 * MiB;
constexpr size_t WS_RS = WS_WHOUT + 8 * MiB;
constexpr size_t WS_BIG = WS_RS + 2 * MiB;
constexpr size_t WS_CV = WS_BIG;
constexpr size_t WS_CG = WS_BIG + 128 * MiB;
constexpr size_t WS_QEF = WS_BIG;
constexpr size_t WS_KIF = WS_BIG + 64 * MiB;
constexpr size_t WS_QEB = WS_BIG + 128 * MiB;
constexpr size_t WS_KIB = WS_BIG + 192 * MiB;
constexpr size_t WS_VV = WS_BIG + 256 * MiB;
constexpr size_t WS_DLF = WS_BIG + 320 * MiB;
constexpr size_t WS_DLB = WS_BIG + 324 * MiB;
constexpr size_t WS_BAR = WS_BIG + 328 * MiB;
constexpr size_t WS_END = WS_BAR + 16384;

typedef __bf16 bf16v2_t __attribute__((ext_vector_type(2)));
typedef float f32x2_t __attribute__((ext_vector_type(2)));
__device__ __forceinline__ unsigned cvt_pk_bf16(float lo, float hi) { const f32x2_t v = {lo, hi}; return __builtin_bit_cast(unsigned, __builtin_convertvector(v, bf16v2_t)); }
__device__ __forceinline__ float bflo(unsigned w) { return __uint_as_float(w << 16); }
__device__ __forceinline__ float bfhi(unsigned w) { return __uint_as_float(w & 0xffff0000u); }
__device__ __forceinline__ float fast_exp2(float x) { return __builtin_amdgcn_exp2f(x); }
__device__ __forceinline__ float fast_exp(float x) { return __builtin_amdgcn_exp2f(x * 1.44269504089f); }
__device__ __forceinline__ float fast_rcp(float x) { return __builtin_amdgcn_rcpf(x); }
template <int CTRL> __device__ __forceinline__ float dppf(float x) { return __int_as_float(__builtin_amdgcn_update_dpp(0, __float_as_int(x), CTRL, 0xf, 0xf, false)); }
__device__ __forceinline__ float row_prefix16(float x) { x += dppf<0x111>(x); x += dppf<0x112>(x); x += dppf<0x114>(x); x += dppf<0x118>(x); return x; }
template <int CTRL> __device__ __forceinline__ float dppf1(float x) { return __int_as_float(__builtin_amdgcn_update_dpp(0x3f800000, __float_as_int(x), CTRL, 0xf, 0xf, false)); }
__device__ __forceinline__ float row_prefprod16(float x) { x *= dppf1<0x111>(x); x *= dppf1<0x112>(x); x *= dppf1<0x114>(x); x *= dppf1<0x118>(x); return x; }
__device__ __forceinline__ float row_sufprod16(float x) { x *= dppf1<0x101>(x); x *= dppf1<0x102>(x); x *= dppf1<0x104>(x); x *= dppf1<0x108>(x); return x; }
__device__ __forceinline__ float row_suffix16(float x) { x += dppf<0x101>(x); x += dppf<0x102>(x); x += dppf<0x104>(x); x += dppf<0x108>(x); return x; }

namespace pg8 {
constexpr int BM = 256, BK = 64, HALF = 128, HTB = HALF * BK * 2, STAGE_BYTES = 8 * HTB, NXCD = 8, WGM = 8;
__host__ __device__ __forceinline__ int lds_byte(int r, int c) { const int st = (r >> 4) * 2 + (c >> 5), rr = r & 15, cc = c & 31, ob = rr * 64 + cc * 2; return st * 1024 + (ob ^ (((ob >> 9) & 1) << 5)); }
__host__ __device__ __forceinline__ void stage_rc(int b, int& R, int& C) { const int st = b / 1024, sb = b % 1024, swz = sb ^ (((sb >> 9) & 1) << 5); R = (st >> 1) * 16 + swz / 64; C = (st & 1) * 32 + (swz % 64) / 2; }
struct Unit { int pm, pn; };
struct Gemm { const bf16_t* A; const bf16_t* Bt; int M, N, K; };
struct StaticOrder {
    int nM, nN, nwg, G, c, wgm;
    __host__ __device__ void init(int M, int N, int G_, int c_, int wgm_ = WGM) { nM = M / BM; nN = N / BM; nwg = nM * nN; G = G_; c = c_; wgm = wgm_; }
    __host__ __device__ bool next(int i, Unit& u) const {
        const long L = (long)i * G + c; if (L >= nwg) return false;
        int wgid = (int)L; { const int q = nwg / NXCD, r = nwg % NXCD, xcd = wgid % NXCD, off = wgid / NXCD; wgid = (xcd < r ? xcd * (q + 1) : r * (q + 1) + (xcd - r) * q) + off; }
        const int nig = wgm * nN, gid = wgid / nig, fm = gid * wgm, gsz = (nM - fm) < wgm ? (nM - fm) : wgm;
        u.pm = fm + ((wgid % nig) % gsz); u.pn = (wgid % nig) / gsz; return true;
    }
};
template <class Epi>
__device__ __forceinline__ void gemm_phase(LAS unsigned char* lds, const Gemm g, const StaticOrder& S, const Epi& E) {
    int tid = threadIdx.x; asm volatile("" : "+v"(tid));
    const int wid = __builtin_amdgcn_readfirstlane(tid >> 6), lane = tid & 63, wr = wid >> 2, wc = wid & 3, fr = lane & 15, fq = lane >> 4;
    const int K = g.K, nt = K / BK;
    unsigned voffA[2];
#pragma unroll
    for (int i = 0; i < 2; ++i) { int R, C; stage_rc(tid * 16 + i * 8192, R, C); voffA[i] = (unsigned)(R * K + C) * 2u; }
    const size_t kstep = (size_t)(BK * 2);
    const size_t hstep = (size_t)HALF * K * 2;
    const size_t tstep = 2 * hstep;
    const unsigned ldsw = (unsigned)wid * 1024u;
    const int aoff = lds_byte(wr * 64 + fr, fq * 8), boff = lds_byte(wc * 32 + fr, fq * 8);
#define PG8_SA(b, h) (((b) * 2 + (h)) * HTB)
#define PG8_SB(b, h) ((4 + (b) * 2 + (h)) * HTB)
#define PG8_STAGE(bufoff, gbase, voff) do { _Pragma("unroll") for (int _i = 0; _i < 2; ++_i) \
        __builtin_amdgcn_global_load_lds((const unsigned*)((const char*)(gbase) + (voff)[_i]), (LAS unsigned*)(lds + (bufoff) + ldsw + _i * 8192), 16, 0, 0); } while (0)
#define PG8_LDA(dst, b, h) do { _Pragma("unroll") for (int m = 0; m < 4; ++m) _Pragma("unroll") for (int k = 0; k < 2; ++k) dst[m][k] = *(const LAS bf16x8*)(lds + PG8_SA(b, h) + aoff + m * 2048 + k * 1024); } while (0)
#define PG8_LDB(dst, b, h) do { _Pragma("unroll") for (int n = 0; n < 2; ++n) _Pragma("unroll") for (int k = 0; k < 2; ++k) dst[n][k] = *(const LAS bf16x8*)(lds + PG8_SB(b, h) + boff + n * 2048 + k * 1024); } while (0)
#define PG8_MMA(ai, bj, At, Bt) do { __builtin_amdgcn_s_setprio(1); _Pragma("unroll") for (int m = 0; m < 4; ++m) _Pragma("unroll") for (int n = 0; n < 2; ++n) _Pragma("unroll") for (int k = 0; k < 2; ++k) \
        acc[ai][bj][m][n] = __builtin_amdgcn_mfma_f32_16x16x32_bf16(Bt[n][k], At[m][k], acc[ai][bj][m][n], 0, 0, 0); __builtin_amdgcn_s_setprio(0); } while (0)
#define PG8_WAIT_V(n) asm volatile("s_waitcnt vmcnt(" #n ")" ::: "memory")
#define PG8_WAIT_L(n) asm volatile("s_waitcnt lgkmcnt(" #n ")" ::: "memory")
#define PG8_BAR __builtin_amdgcn_s_barrier()
#define PG8_SCHED __builtin_amdgcn_sched_barrier(0)
    Unit cur, nxt; int ui = 0;
    if (!S.next(0, cur)) return;
    f32x4 acc[2][2][4][2];
#pragma unroll
    for (int a = 0; a < 2; ++a)
#pragma unroll
        for (int b = 0; b < 2; ++b)
#pragma unroll
            for (int m = 0; m < 4; ++m)
#pragma unroll
                for (int n = 0; n < 2; ++n) acc[a][b][m][n] = (f32x4){0.f, 0.f, 0.f, 0.f};
    bf16x8 At[4][2], B0[2][2], B1[2][2];
    const char* cA = (const char*)g.A + (size_t)cur.pm * tstep; const char* cB = (const char*)g.Bt + (size_t)cur.pn * tstep;
    PG8_STAGE(PG8_SB(0, 0), cB, voffA); PG8_STAGE(PG8_SB(0, 1), cB + hstep, voffA); PG8_STAGE(PG8_SA(0, 0), cA, voffA); PG8_STAGE(PG8_SA(0, 1), cA + hstep, voffA);
    if (wr == 1) PG8_BAR;
    PG8_WAIT_V(2); PG8_BAR;
    PG8_STAGE(PG8_SB(1, 0), cB + kstep, voffA); PG8_STAGE(PG8_SA(1, 0), cA + kstep, voffA); PG8_STAGE(PG8_SB(1, 1), cB + hstep + kstep, voffA);
    PG8_WAIT_V(6); PG8_BAR;
    for (;;) {
        const bool has_next = S.next(ui + 1, nxt);
        const char* nA = has_next ? (const char*)g.A + (size_t)nxt.pm * tstep : cA; const char* nB = has_next ? (const char*)g.Bt + (size_t)nxt.pn * tstep : cB;
        for (int t = 0; t < nt; t += 2) {
            const bool last = (t == nt - 2);
            const char* a1 = cA + (size_t)(t + 1) * kstep;
            const char* a2 = last ? nA : cA + (size_t)(t + 2) * kstep; const char* b2 = last ? nB : cB + (size_t)(t + 2) * kstep;
            const char* a3 = a2 + kstep; const char* b3 = b2 + kstep;
            PG8_LDB(B0, 0, 0); PG8_LDB(B1, 0, 1); PG8_SCHED; PG8_LDA(At, 0, 0); PG8_STAGE(PG8_SA(1, 1), a1 + hstep, voffA);
            PG8_WAIT_V(8); PG8_WAIT_L(0); PG8_BAR; PG8_MMA(0, 0, At, B0); PG8_MMA(0, 1, At, B1); PG8_BAR; PG8_SCHED;
            PG8_LDA(At, 0, 1); PG8_STAGE(PG8_SB(0, 0), b2, voffA); PG8_STAGE(PG8_SB(0, 1), b2 + hstep, voffA); PG8_STAGE(PG8_SA(0, 0), a2, voffA);
            PG8_WAIT_V(8); PG8_WAIT_L(0); PG8_BAR; PG8_MMA(1, 0, At, B0); PG8_MMA(1, 1, At, B1); PG8_BAR; PG8_SCHED;
            PG8_LDB(B0, 1, 0); PG8_LDB(B1, 1, 1); PG8_SCHED; PG8_LDA(At, 1, 0); PG8_STAGE(PG8_SA(0, 1), a2 + hstep, voffA);
            PG8_WAIT_V(8); PG8_WAIT_L(0); PG8_BAR; PG8_MMA(0, 0, At, B0); PG8_MMA(0, 1, At, B1); PG8_BAR; PG8_SCHED;
            PG8_LDA(At, 1, 1); PG8_STAGE(PG8_SB(1, 0), b3, voffA); PG8_STAGE(PG8_SB(1, 1), b3 + hstep, voffA); PG8_STAGE(PG8_SA(1, 0), a3, voffA);
            PG8_WAIT_V(8); PG8_WAIT_L(0); PG8_BAR; PG8_MMA(1, 0, At, B0); PG8_MMA(1, 1, At, B1); PG8_BAR; PG8_SCHED;
        }
        if (wr == 0) PG8_BAR;
        E(acc, cur, wr, wc, fr, fq);
        if (!has_next) break;
#pragma unroll
        for (int a = 0; a < 2; ++a)
#pragma unroll
            for (int b = 0; b < 2; ++b)
#pragma unroll
                for (int m = 0; m < 4; ++m)
#pragma unroll
                    for (int n = 0; n < 2; ++n) acc[a][b][m][n] = (f32x4){0.f, 0.f, 0.f, 0.f};
        cur = nxt; cA = nA; cB = nB; ++ui;
        if (wr == 1) PG8_BAR;
    }
    PG8_WAIT_V(0);
    PG8_BAR;
#undef PG8_SA
#undef PG8_SB
#undef PG8_STAGE
#undef PG8_LDA
#undef PG8_LDB
#undef PG8_MMA
#undef PG8_WAIT_V
#undef PG8_WAIT_L
#undef PG8_BAR
#undef PG8_SCHED
}
}

__device__ __forceinline__ float row_rscale(const float* __restrict__ rs, int row, int fq) {
    const float* p = rs + (size_t)(4 * fq) * MT + row;
    float s = (p[0] + p[MT]) + (p[2 * (size_t)MT] + p[3 * (size_t)MT]);
    s += __shfl_xor(s, 16); s += __shfl_xor(s, 32);
    return rsqrtf(s * (1.0f / DM) + EPSV);
}
__device__ __forceinline__ void row_rscale8(const float* __restrict__ rs, int row0, int fq, float (&r)[2][4]) {
    float s[2][4];
#pragma unroll
    for (int ai = 0; ai < 2; ++ai)
#pragma unroll
        for (int m = 0; m < 4; ++m) { const float* p = rs + (size_t)(4 * fq) * MT + row0 + ai * 128 + m * 16; s[ai][m] = (p[0] + p[MT]) + (p[2 * (size_t)MT] + p[3 * (size_t)MT]); }
#pragma unroll
    for (int ai = 0; ai < 2; ++ai)
#pragma unroll
        for (int m = 0; m < 4; ++m) { float t = s[ai][m]; t += __shfl_xor(t, 16); t += __shfl_xor(t, 32); r[ai][m] = rsqrtf(t * (1.0f / DM) + EPSV); }
}

__device__ __forceinline__ void store_pair16(bf16_t* xp, bf16_t* yp, u32x2 x, u32x2 y, int fq) {
    const u32x2 r0 = __builtin_amdgcn_permlane16_swap(x.x, y.x, false, false);
    const u32x2 r1 = __builtin_amdgcn_permlane16_swap(x.y, y.y, false, false);
    u32x4 d; d.x = r0.x; d.y = r1.x; d.z = r0.y; d.w = r1.y;
    bf16_t* p = (fq & 1) ? (yp - 4) : xp;
    *(u32x4*)p = d;
}

struct RCtx { const LAS float* rl; int pmA, pmB; };
__device__ __forceinline__ RCtx fill_row_scales(LAS unsigned char* lds, const pg8::StaticOrder& S, const float* __restrict__ rs, int row_base) {
    RCtx rc; rc.rl = (const LAS float*)(lds + pg8::STAGE_BYTES + 16); rc.pmA = 0; rc.pmB = 0;
    pg8::Unit u0, ul;
    if (S.next(0, u0)) {
        const int nun = (int)(((long)S.nwg - S.c + S.G - 1) / S.G); S.next(nun - 1, ul);
        rc.pmA = u0.pm; rc.pmB = ul.pm;
        const int tid = threadIdx.x, pm = (tid >> 8) ? ul.pm : u0.pm;
        const float* p = rs + (size_t)(row_base + pm * 256 + (tid & 255));
        float s0 = 0.f, s1 = 0.f, s2 = 0.f, s3 = 0.f;
#pragma unroll
        for (int k = 0; k < 4; ++k) { s0 += p[(size_t)(4 * k) * MT]; s1 += p[(size_t)(4 * k + 1) * MT]; s2 += p[(size_t)(4 * k + 2) * MT]; s3 += p[(size_t)(4 * k + 3) * MT]; }
        ((LAS float*)(lds + pg8::STAGE_BYTES + 16))[tid] = rsqrtf(((s0 + s1) + (s2 + s3)) * (1.0f / DM) + EPSV);
    }
    __syncthreads();
    return rc;
}
__device__ __forceinline__ void row_rscale8c(const RCtx& rc, const float* __restrict__ rs, int grow0, int pm, int lr0, int fq, float (&r)[2][4]) {
    if (pm == rc.pmA || pm == rc.pmB) {
        const LAS float* p = rc.rl + ((pm == rc.pmA) ? 0 : 256) + lr0;
#pragma unroll
        for (int ai = 0; ai < 2; ++ai)
#pragma unroll
            for (int m = 0; m < 4; ++m) r[ai][m] = p[ai * 128 + m * 16];
    } else row_rscale8(rs, grow0, fq, r);
}

struct EpiConv1 {
    const float* rs; bf16_t* Y; bf16_t* VE; bf16_t* GE; const float* ck; RCtx rc; bf16_t* Yhi;
    __device__ __forceinline__ void operator()(const f32x4 (&acc)[2][2][4][2], const pg8::Unit& u, int wr, int wc, int fr, int fq) const {
        const int e0 = u.pn * 64 + wc * 16 + fq * 4;
        float rsc[2][4]; row_rscale8c(rc, rs, u.pm * 256 + wr * 64 + fr, u.pm, wr * 64 + fr, fq, rsc);
        const f32x4 k0 = *(const f32x4*)(ck + e0), k1 = *(const f32x4*)(ck + EI + e0), k2 = *(const f32x4*)(ck + 2 * EI + e0);
#pragma unroll
        for (int ai = 0; ai < 2; ++ai) {
            float v[4][4], gg[4][4];
#pragma unroll
            for (int m = 0; m < 4; ++m) {
                const float r = rsc[ai][m];
                const f32x4 b = acc[ai][0][m][0] * r, c = acc[ai][0][m][1] * r, uu = acc[ai][1][m][0] * r, z = acc[ai][1][m][1] * r;
#pragma unroll
                for (int j = 0; j < 4; ++j) { v[m][j] = c[j] * uu[j]; gg[m][j] = b[j] * z[j] * fast_rcp(1.0f + fast_exp(-z[j])); }
            }
            const int blk = u.pm * 4 + ai * 2 + wr;
#pragma unroll
            for (int m = 0; m < 4; ++m) {
                const int row = u.pm * 256 + ai * 128 + wr * 64 + m * 16 + fr;
                float y[4];
#pragma unroll
                for (int j = 0; j < 4; ++j) {
                    const float pown = dppf<0x121>(v[m][j]);
                    const float pup = (m > 0) ? dppf<0x121>(v[m > 0 ? m - 1 : 0][j]) : 0.f;
                    const float nown = dppf<0x12f>(v[m][j]);
                    const float ndn = (m < 3) ? dppf<0x12f>(v[m < 3 ? m + 1 : 3][j]) : 0.f;
                    const float prev = (fr > 0) ? pown : pup, next = (fr < 15) ? nown : ndn;
                    y[j] = gg[m][j] * (k0[j] * prev + k1[j] * v[m][j] + k2[j] * next);
                }
                u32x2 wy; wy.x = cvt_pk_bf16(y[0], y[1]); wy.y = cvt_pk_bf16(y[2], y[3]);
                *(u32x2*)(((u.pm >= MH / 256) ? Yhi : Y) + (size_t)row * EI + e0) = wy;
                if (m == 0 || m == 3) {
                    u32x2 wv, wg; wv.x = cvt_pk_bf16(v[m][0], v[m][1]); wv.y = cvt_pk_bf16(v[m][2], v[m][3]); wg.x = cvt_pk_bf16(gg[m][0], gg[m][1]); wg.y = cvt_pk_bf16(gg[m][2], gg[m][3]);
                    if (m == 0 && fr < 2) *(u32x2*)(VE + ((size_t)blk * 4 + 2 + fr) * EI + e0) = wv;
                    if (m == 3 && fr >= 14) *(u32x2*)(VE + ((size_t)blk * 4 + (fr - 14)) * EI + e0) = wv;
                    if (m == 0 && fr == 0) *(u32x2*)(GE + ((size_t)blk * 2 + 1) * EI + e0) = wg;
                    if (m == 3 && fr == 15) *(u32x2*)(GE + ((size_t)blk * 2 + 0) * EI + e0) = wg;
                }
            }
        }
    }
};
struct EpiRes {
    bf16_t* xb; float* rs; int row_base;
    __device__ __forceinline__ void operator()(const f32x4 (&acc)[2][2][4][2], const pg8::Unit& u, int wr, int wc, int fr, int fq) const {
        bf16_t* base = xb + (size_t)(row_base + u.pm * 256 + wr * 64 + fr) * DM + u.pn * 256 + wc * 32 + fq * 4;
#pragma unroll
        for (int ai = 0; ai < 2; ++ai) {
            u32x2 xr[4][2][2];
#pragma unroll
            for (int m = 0; m < 4; ++m)
#pragma unroll
                for (int bj = 0; bj < 2; ++bj)
#pragma unroll
                    for (int n = 0; n < 2; ++n) xr[m][bj][n] = *(const u32x2*)(base + (size_t)(ai * 128 + m * 16) * DM + bj * 128 + n * 16);
#pragma unroll
            for (int m = 0; m < 4; ++m) {
                const int row = row_base + u.pm * 256 + ai * 128 + wr * 64 + m * 16 + fr;
                float ss = 0.f;
#pragma unroll
                for (int bj = 0; bj < 2; ++bj) {
                    u32x2 wn[2];
#pragma unroll
                    for (int n = 0; n < 2; ++n) {
                        const u32x2 xo = xr[m][bj][n]; const f32x4 a = acc[ai][bj][m][n];
                        const float x0 = bflo(xo.x) + a[0], x1 = bfhi(xo.x) + a[1], x2 = bflo(xo.y) + a[2], x3 = bfhi(xo.y) + a[3];
                        wn[n].x = cvt_pk_bf16(x0, x1); wn[n].y = cvt_pk_bf16(x2, x3);
                        ss += (x0 * x0 + x1 * x1) + (x2 * x2 + x3 * x3);
                    }
                    bf16_t* q = base + (size_t)(ai * 128 + m * 16) * DM + bj * 128;
                    store_pair16(q, q + 16, wn[0], wn[1], fq);
                }
                ss += __shfl_xor(ss, 16); ss += __shfl_xor(ss, 32);
                if (fq == 0) rs[(size_t)(u.pn * 4 + wc) * MT + row] = ss;
            }
        }
    }
};
struct EpiZ {
    const float* rs; bf16_t* ON; int row_base;
    __device__ __forceinline__ void operator()(const f32x4 (&acc)[2][2][4][2], const pg8::Unit& u, int wr, int wc, int fr, int fq) const {
        bf16_t* base = ON + (size_t)(u.pm * 256 + wr * 64 + fr) * EI + u.pn * 256 + wc * 32 + fq * 4;
        float rsc[2][4]; row_rscale8(rs, row_base + u.pm * 256 + wr * 64 + fr, fq, rsc);
#pragma unroll
        for (int ai = 0; ai < 2; ++ai) {
            u32x2 xr[4][2][2];
#pragma unroll
            for (int m = 0; m < 4; ++m)
#pragma unroll
                for (int bj = 0; bj < 2; ++bj)
#pragma unroll
                    for (int n = 0; n < 2; ++n) xr[m][bj][n] = *(const u32x2*)(base + (size_t)(ai * 128 + m * 16) * EI + bj * 128 + n * 16);
#pragma unroll
            for (int m = 0; m < 4; ++m) {
                const float r = rsc[ai][m];
#pragma unroll
                for (int bj = 0; bj < 2; ++bj)
#pragma unroll
                    for (int n = 0; n < 2; ++n) {
                        const u32x2 o = xr[m][bj][n]; const f32x4 z = acc[ai][bj][m][n] * r;
                        const float o0 = bflo(o.x), o1 = bfhi(o.x), o2 = bflo(o.y), o3 = bfhi(o.y);
                        const float y0 = o0 * z[0] * fast_rcp(1.0f + fast_exp(-z[0])), y1 = o1 * z[1] * fast_rcp(1.0f + fast_exp(-z[1]));
                        const float y2 = o2 * z[2] * fast_rcp(1.0f + fast_exp(-z[2])), y3 = o3 * z[3] * fast_rcp(1.0f + fast_exp(-z[3]));
                        u32x2 w; w.x = cvt_pk_bf16(y0, y1); w.y = cvt_pk_bf16(y2, y3);
                        *(u32x2*)(base + (size_t)(ai * 128 + m * 16) * EI + bj * 128 + n * 16) = w;
                    }
            }
        }
    }
};
__device__ __forceinline__ size_t hm_off(int lrow, int e) { return (size_t)(lrow >> 12) * ((size_t)EI * SEQ) + (size_t)(e >> 7) * ((size_t)SEQ * 128) + (size_t)(lrow & (SEQ - 1)) * 128 + (e & 127); }
struct EpiH1 {
    const float* rs; const float* lbl; int layer_j; int row_base;
    bf16_t *QEF, *KIF, *QEB, *KIB, *VV; float *DLF, *DLB; bf16_t* SZ; RCtx rc;
    __device__ __forceinline__ void operator()(const f32x4 (&acc)[2][2][4][2], const pg8::Unit& u, int wr, int wc, int fr, int fq) const {
        if (u.pn >= 32) {
            float rz[2][4]; row_rscale8c(rc, rs, row_base + u.pm * 256 + wr * 64 + fr, u.pm, wr * 64 + fr, fq, rz);
            bf16_t* base = SZ + (size_t)(u.pm * 256 + wr * 64 + fr) * EI + (u.pn - 32) * 256 + wc * 32 + fq * 4;
#pragma unroll
            for (int ai = 0; ai < 2; ++ai)
#pragma unroll
                for (int m = 0; m < 4; ++m)
#pragma unroll
                    for (int bj = 0; bj < 2; ++bj) {
                        u32x2 wn[2];
#pragma unroll
                        for (int n = 0; n < 2; ++n) {
                            const f32x4 z = acc[ai][bj][m][n] * rz[ai][m];
                            const float y0 = z[0] * fast_rcp(1.0f + fast_exp(-z[0])), y1 = z[1] * fast_rcp(1.0f + fast_exp(-z[1]));
                            const float y2 = z[2] * fast_rcp(1.0f + fast_exp(-z[2])), y3 = z[3] * fast_rcp(1.0f + fast_exp(-z[3]));
                            wn[n].x = cvt_pk_bf16(y0, y1); wn[n].y = cvt_pk_bf16(y2, y3);
                        }
                        bf16_t* q = base + (size_t)(ai * 128 + m * 16) * EI + bj * 128;
                        store_pair16(q, q + 16, wn[0], wn[1], fq);
                    }
            return;
        }
        const int e0 = u.pn * 64 + wc * 16 + fq * 4;
        float oml[4];
#pragma unroll
        for (int j = 0; j < 4; ++j) {
            float lb = 0.f;
            if (layer_j == 1) { const float l0 = lbl[e0 + j], l1 = lbl[EI + e0 + j], mx = fmaxf(l0, l1), a0 = __expf(l0 - mx), a1 = __expf(l1 - mx), sm = a0 + a1, p0 = a0 / sm, p1 = a1 / sm; lb = (p0 + p1) - p0; }
            lb = fminf(fmaxf(lb, 0.f), 1.0f - 1e-6f);
            oml[j] = 1.0f - lb;
        }
        const float qscale = 0.08838834764831845f;
        float rsc[2][4]; row_rscale8c(rc, rs, row_base + u.pm * 256 + wr * 64 + fr, u.pm, wr * 64 + fr, fq, rsc);
#pragma unroll
        for (int ai = 0; ai < 2; ++ai)
#pragma unroll
            for (int mm = 0; mm < 2; ++mm) {
                const int m0 = 2 * mm, m1 = 2 * mm + 1;
                const int lrow0 = u.pm * 256 + ai * 128 + wr * 64 + m0 * 16 + fr, lrow1 = lrow0 + 16;
                const float r0 = rsc[ai][m0], r1 = rsc[ai][m1], r0l = r0 * 1.44269504089f, r1l = r1 * 1.44269504089f;
                float qf0[4], qf1[4], kf0[4], kf1[4], qb0[4], qb1[4], kb0[4], kb1[4], dlf[4], dlb[4];
#pragma unroll
                for (int j = 0; j < 4; ++j) {
                    const float q0 = acc[ai][0][m0][0][j] * (r0 * qscale), q1 = acc[ai][0][m1][0][j] * (r1 * qscale);
                    {
                        const float k0 = oml[j] * fast_rcp(1.0f + fast_exp2(acc[ai][0][m0][1][j] * r0l)), k1 = oml[j] * fast_rcp(1.0f + fast_exp2(acc[ai][0][m1][1][j] * r1l));
                        const float e0_ = row_prefprod16(1.0f - k0); const float e1_ = row_prefprod16(1.0f - k1) * dppf<0x15f>(e0_);
                        const float E0 = fmaxf(e0_, 1e-30f), E1 = fmaxf(e1_, 1e-30f);
                        qf0[j] = q0 * E0; qf1[j] = q1 * E1; kf0[j] = k0 * fast_rcp(E0); kf1[j] = k1 * fast_rcp(E1);
                        dlf[j] = E1;
                    }
                    {
                        const float k0 = oml[j] * fast_rcp(1.0f + fast_exp2(acc[ai][1][m0][0][j] * r0l)), k1 = oml[j] * fast_rcp(1.0f + fast_exp2(acc[ai][1][m1][0][j] * r1l));
                        const float e1_ = row_sufprod16(1.0f - k1); const float e0_ = row_sufprod16(1.0f - k0) * dppf<0x150>(e1_);
                        const float E0 = fmaxf(e0_, 1e-30f), E1 = fmaxf(e1_, 1e-30f);
                        qb0[j] = q0 * E0; qb1[j] = q1 * E1; kb0[j] = k0 * fast_rcp(E0); kb1[j] = k1 * fast_rcp(E1);
                        dlb[j] = E0;
                    }
                }
                const size_t o0 = hm_off(lrow0, e0), o1 = o0 + 16 * 128;
                u32x2 wa, wb;
                wa.x = cvt_pk_bf16(qf0[0], qf0[1]); wa.y = cvt_pk_bf16(qf0[2], qf0[3]); wb.x = cvt_pk_bf16(kf0[0], kf0[1]); wb.y = cvt_pk_bf16(kf0[2], kf0[3]); store_pair16(QEF + o0, KIF + o0, wa, wb, fq);
                wa.x = cvt_pk_bf16(qf1[0], qf1[1]); wa.y = cvt_pk_bf16(qf1[2], qf1[3]); wb.x = cvt_pk_bf16(kf1[0], kf1[1]); wb.y = cvt_pk_bf16(kf1[2], kf1[3]); store_pair16(QEF + o1, KIF + o1, wa, wb, fq);
                wa.x = cvt_pk_bf16(qb0[0], qb0[1]); wa.y = cvt_pk_bf16(qb0[2], qb0[3]); wb.x = cvt_pk_bf16(kb0[0], kb0[1]); wb.y = cvt_pk_bf16(kb0[2], kb0[3]); store_pair16(QEB + o0, KIB + o0, wa, wb, fq);
                wa.x = cvt_pk_bf16(qb1[0], qb1[1]); wa.y = cvt_pk_bf16(qb1[2], qb1[3]); wb.x = cvt_pk_bf16(kb1[0], kb1[1]); wb.y = cvt_pk_bf16(kb1[2], kb1[3]); store_pair16(QEB + o1, KIB + o1, wa, wb, fq);
                const f32x4 i0 = acc[ai][1][m0][1] * r0, i1 = acc[ai][1][m1][1] * r1;
                wa.x = cvt_pk_bf16(i0[0], i0[1]); wa.y = cvt_pk_bf16(i0[2], i0[3]); wb.x = cvt_pk_bf16(i1[0], i1[1]); wb.y = cvt_pk_bf16(i1[2], i1[3]); store_pair16(VV + o0, VV + o1, wa, wb, fq);
                const size_t oc = (size_t)(lrow0 >> 5) * EI + e0;
                if (fr == 15) *(f32x4*)(DLF + oc) = (f32x4){dlf[0], dlf[1], dlf[2], dlf[3]};
                if (fr == 0) *(f32x4*)(DLB + oc) = (f32x4){dlb[0], dlb[1], dlb[2], dlb[3]};
            }
    }
};

struct EpiSZ {
    const float* rs; int row_base; bf16_t* SZ; RCtx rc;
    __device__ __forceinline__ void operator()(const f32x4 (&acc)[2][2][4][2], const pg8::Unit& u, int wr, int wc, int fr, int fq) const {
            float rz[2][4]; row_rscale8c(rc, rs, row_base + u.pm * 256 + wr * 64 + fr, u.pm, wr * 64 + fr, fq, rz);
            bf16_t* base = SZ + (size_t)(u.pm * 256 + wr * 64 + fr) * EI + u.pn * 256 + wc * 32 + fq * 4;
#pragma unroll
            for (int ai = 0; ai < 2; ++ai)
#pragma unroll
                for (int m = 0; m < 4; ++m)
#pragma unroll
                    for (int bj = 0; bj < 2; ++bj) {
                        u32x2 wn[2];
#pragma unroll
                        for (int n = 0; n < 2; ++n) {
                            const f32x4 z = acc[ai][bj][m][n] * rz[ai][m];
                            const float y0 = z[0] * fast_rcp(1.0f + fast_exp(-z[0])), y1 = z[1] * fast_rcp(1.0f + fast_exp(-z[1]));
                            const float y2 = z[2] * fast_rcp(1.0f + fast_exp(-z[2])), y3 = z[3] * fast_rcp(1.0f + fast_exp(-z[3]));
                            wn[n].x = cvt_pk_bf16(y0, y1); wn[n].y = cvt_pk_bf16(y2, y3);
                        }
                        bf16_t* q = base + (size_t)(ai * 128 + m * 16) * EI + bj * 128;
                        store_pair16(q, q + 16, wn[0], wn[1], fq);
                    }
    }
};

__device__ __forceinline__ int perm_col(int col) {
    const int type = col >> 11, e = col & 2047;
    return (e >> 6) * 256 + (type >> 1) * 128 + ((e >> 4) & 3) * 32 + (type & 1) * 16 + ((e >> 2) & 3) * 4 + (e & 3);
}
struct TileDesc { const float* src; const float* nw; bf16_t* dst; int ld_src, ld_dst, k0, c0, perm_limit; };
struct Params {
    const float* x; const float* norm_w; const float* final_norm_w; const float* conv_w_in; const float* conv_kernel; const float* conv_w_out;
    const float* hgrn_w_in; const float* hgrn_lb; const float* hgrn_norm_w; const float* hgrn_w_out;
    float* out; unsigned char* ws; int never; int pad;
};
__device__ __forceinline__ TileDesc tile_desc(const Params& P, int t) {
    TileDesc d;
    if (t < 4096) { const int l = t >> 11, r = t & 2047, kt = r >> 7, ct = r & 127;
        d.src = P.conv_w_in + (size_t)l * DM * 8192; d.ld_src = 8192; d.k0 = kt * 64; d.c0 = ct * 64; d.nw = P.norm_w + (size_t)(2 * l) * DM; d.dst = (bf16_t*)(P.ws + WS_WCIN) + (size_t)l * 8192 * DM; d.ld_dst = DM; d.perm_limit = 8192;
    } else if (t < 4096 + 5120) { const int q = t - 4096, l = q / 2560, r = q % 2560, kt = r / 160, ct = r % 160;
        d.src = P.hgrn_w_in + (size_t)l * DM * 10240; d.ld_src = 10240; d.k0 = kt * 64; d.c0 = ct * 64; d.nw = P.norm_w + (size_t)(2 * l + 1) * DM; d.dst = (bf16_t*)(P.ws + WS_WHIN) + (size_t)l * 10240 * DM; d.ld_dst = DM; d.perm_limit = 8192;
    } else if (t < 4096 + 5120 + 1024) { const int q = t - 9216, l = q >> 9, r = q & 511, kt = r >> 4, ct = r & 15;
        d.src = P.conv_w_out + (size_t)l * EI * DM; d.ld_src = DM; d.k0 = kt * 64; d.c0 = ct * 64; d.nw = nullptr; d.dst = (bf16_t*)(P.ws + WS_WCOUT) + (size_t)l * DM * EI; d.ld_dst = EI; d.perm_limit = 0;
    } else { const int q = t - 10240, l = q >> 9, r = q & 511, kt = r >> 4, ct = r & 15;
        d.src = P.hgrn_w_out + (size_t)l * EI * DM; d.ld_src = DM; d.k0 = kt * 64; d.c0 = ct * 64; d.nw = nullptr; d.dst = (bf16_t*)(P.ws + WS_WHOUT) + (size_t)l * DM * EI; d.ld_dst = EI; d.perm_limit = 0;
    }
    return d;
}

__device__ __forceinline__ void prologue(const Params& P, LAS unsigned char* lds) {
    LAS float* tiles = (LAS float*)lds;
    const int G = gridDim.x, bid = blockIdx.x, tid = threadIdx.x;
    constexpr int NT = 4096 + 5120 + 1024 + 1024, NG = NT / 4;
    for (int grp = bid; grp < NG; grp += G) {
        f32x4 v[4][2];
        const int rr = tid >> 4, cc = (tid & 15) * 4;
#pragma unroll
        for (int q = 0; q < 4; ++q) { const TileDesc d = tile_desc(P, grp * 4 + q);
#pragma unroll
            for (int p = 0; p < 2; ++p) v[q][p] = *(const f32x4*)(d.src + (size_t)(d.k0 + rr + 32 * p) * d.ld_src + d.c0 + cc); }
#pragma unroll
        for (int q = 0; q < 4; ++q)
#pragma unroll
            for (int p = 0; p < 2; ++p) { LAS float* t = tiles + q * (64 * 65) + (rr + 32 * p) * 65 + cc; t[0] = v[q][p][0]; t[1] = v[q][p][1]; t[2] = v[q][p][2]; t[3] = v[q][p][3]; }
        __syncthreads();
        const int c = tid >> 3, ks = (tid & 7) * 8;
#pragma unroll
        for (int q = 0; q < 4; ++q) { const TileDesc d = tile_desc(P, grp * 4 + q);
            float w8[8];
#pragma unroll
            for (int i = 0; i < 8; ++i) { w8[i] = tiles[q * (64 * 65) + (ks + i) * 65 + c]; if (d.nw) w8[i] *= d.nw[d.k0 + ks + i]; }
            const int col = d.c0 + c, drow = (col < d.perm_limit) ? perm_col(col) : col;
            u32x4 w; w.x = cvt_pk_bf16(w8[0], w8[1]); w.y = cvt_pk_bf16(w8[2], w8[3]); w.z = cvt_pk_bf16(w8[4], w8[5]); w.w = cvt_pk_bf16(w8[6], w8[7]);
            *(u32x4*)(d.dst + (size_t)drow * d.ld_dst + d.k0 + ks) = w; }
        __syncthreads();
    }
    const int lane = tid & 63, gw = bid * 8 + (tid >> 6), nw_ = G * 8;
    bf16_t* xb = (bf16_t*)(P.ws + WS_XB); float* rs = (float*)(P.ws + WS_RS);
    for (int row = gw; row < MT; row += 2 * nw_) {
        f32x4 v[2][4];
#pragma unroll
        for (int q = 0; q < 2; ++q)
#pragma unroll
            for (int i = 0; i < 4; ++i) v[q][i] = *(const f32x4*)(P.x + (size_t)(row + q * nw_) * DM + i * 256 + lane * 4);
#pragma unroll
        for (int q = 0; q < 2; ++q) {
            float ss = 0.f;
#pragma unroll
            for (int i = 0; i < 4; ++i) {
                const f32x4 a = v[q][i];
                ss += (a[0] * a[0] + a[1] * a[1]) + (a[2] * a[2] + a[3] * a[3]);
                u32x2 w; w.x = cvt_pk_bf16(a[0], a[1]); w.y = cvt_pk_bf16(a[2], a[3]); *(u32x2*)(xb + (size_t)(row + q * nw_) * DM + i * 256 + lane * 4) = w;
            }
#pragma unroll
            for (int o = 32; o >= 1; o >>= 1) ss += __shfl_xor(ss, o);
            if (lane < 16) rs[(size_t)lane * MT + row + q * nw_] = lane == 0 ? ss : 0.f;
        }
    }
}

__device__ __forceinline__ void conv_fix(bf16_t* Y, bf16_t* Yhi, const bf16_t* __restrict__ VE, const bf16_t* __restrict__ GE, const float* __restrict__ ck  ) {
    const int nthreads = gridDim.x * 512; constexpr int NBLK = MT / 64;
    for (int task = blockIdx.x * 512 + threadIdx.x; task < (NBLK + 1) * 256; task += nthreads) {
        const int ec = task & 255, B = task >> 8, e0 = ec * 8, t = 64 * B;
        const bool seqb = (t & (SEQ - 1)) == 0, hasp = B > 0, hasn = B < NBLK;
        const u32x4 zero = (u32x4){0u, 0u, 0u, 0u};
        u32x4 va = zero, vb = zero, gb = zero, vc = zero, vd = zero, gc = zero;
        if (hasp) { va = *(const u32x4*)(VE + ((size_t)(B - 1) * 4 + 0) * EI + e0); vb = *(const u32x4*)(VE + ((size_t)(B - 1) * 4 + 1) * EI + e0); gb = *(const u32x4*)(GE + ((size_t)(B - 1) * 2 + 0) * EI + e0); }
        if (hasn) { vc = *(const u32x4*)(VE + ((size_t)B * 4 + 2) * EI + e0); vd = *(const u32x4*)(VE + ((size_t)B * 4 + 3) * EI + e0); gc = *(const u32x4*)(GE + ((size_t)B * 2 + 1) * EI + e0); }
        float k0[8], k1[8], k2[8];
#pragma unroll
        for (int i = 0; i < 8; ++i) { k0[i] = ck[e0 + i]; k1[i] = ck[EI + e0 + i]; k2[i] = ck[2 * EI + e0 + i]; }
        const u32x4 vcn = seqb ? zero : vc, vbp = seqb ? zero : vb;
        float y1[8], y2[8];
#pragma unroll
        for (int h = 0; h < 4; ++h) {
            y1[2 * h] = bflo(gb[h]) * (k0[2 * h] * bflo(va[h]) + k1[2 * h] * bflo(vb[h]) + k2[2 * h] * bflo(vcn[h]));
            y1[2 * h + 1] = bfhi(gb[h]) * (k0[2 * h + 1] * bfhi(va[h]) + k1[2 * h + 1] * bfhi(vb[h]) + k2[2 * h + 1] * bfhi(vcn[h]));
            y2[2 * h] = bflo(gc[h]) * (k0[2 * h] * bflo(vbp[h]) + k1[2 * h] * bflo(vc[h]) + k2[2 * h] * bflo(vd[h]));
            y2[2 * h + 1] = bfhi(gc[h]) * (k0[2 * h + 1] * bfhi(vbp[h]) + k1[2 * h + 1] * bfhi(vc[h]) + k2[2 * h + 1] * bfhi(vd[h]));
        }
        if (hasp) { u32x4 w; w.x = cvt_pk_bf16(y1[0], y1[1]); w.y = cvt_pk_bf16(y1[2], y1[3]); w.z = cvt_pk_bf16(y1[4], y1[5]); w.w = cvt_pk_bf16(y1[6], y1[7]); *(u32x4*)(((t - 1 >= MH) ? Yhi : Y) + (size_t)(t - 1) * EI + e0) = w; }
        if (hasn) { u32x4 w; w.x = cvt_pk_bf16(y2[0], y2[1]); w.y = cvt_pk_bf16(y2[2], y2[3]); w.z = cvt_pk_bf16(y2[4], y2[5]); w.w = cvt_pk_bf16(y2[6], y2[7]); *(u32x4*)(((t >= MH) ? Yhi : Y) + (size_t)t * EI + e0) = w; }
    }
}

__device__ __forceinline__ unsigned offb(unsigned row, unsigned ch) { return 256u * row + 16u * (ch ^ (((row & 3u) << 2) | ((row >> 2) & 3u))); }
constexpr int SCAN_BUF = 8192 + 8192 + 8192 + 512;
constexpr int SCAN_XCH = 2 * SCAN_BUF;
__device__ __forceinline__ bf16x8 pack8(const f32x4 a, const f32x4 b) {
    u32x4 w; w.x = cvt_pk_bf16(a[0], a[1]); w.y = cvt_pk_bf16(a[2], a[3]); w.z = cvt_pk_bf16(b[0], b[1]); w.w = cvt_pk_bf16(b[2], b[3]);
    return __builtin_bit_cast(bf16x8, w);
}
__device__ __forceinline__ bf16x8 join8(u32x2 lo, u32x2 hi) { u32x4 w; w.x = lo.x; w.y = lo.y; w.z = hi.x; w.w = hi.y; return __builtin_bit_cast(bf16x8, w); }

__device__ __forceinline__ void scan_phase(LAS unsigned char* lds, bf16_t* QEF, const bf16_t* __restrict__ KIF, bf16_t* QEB, const bf16_t* __restrict__ KIB,
                                           const bf16_t* __restrict__ VV, const float* __restrict__ DLF, const float* __restrict__ DLB) {
    int tid = threadIdx.x; asm volatile("" : "+v"(tid));
    const int lane = tid & 63, w = __builtin_amdgcn_readfirstlane(tid >> 6), c = lane & 15, g = lane >> 4, kh = w >> 2, vq = w & 3;
    const unsigned lbase = (unsigned)(unsigned long long)lds;
    for (int item = blockIdx.x; item < 128; item += gridDim.x) {
        const int dir = item & 1, h = (item >> 1) & 15, b = item >> 5;
        bf16_t* QE = dir ? QEB : QEF; const bf16_t* KI = dir ? KIB : KIF; const float* DL = dir ? DLB : DLF;
        const int lrow = tid >> 4, lch = tid & 15;
        const size_t hbase = (size_t)b * ((size_t)EI * SEQ) + (size_t)h * ((size_t)SEQ * 128);
        const bf16_t* qk_src = ((lch < 8) ? (const bf16_t*)QE : KI) + hbase + (size_t)lrow * 128 + (lch & 7) * 8;
        const bf16_t* v_src = VV + hbase + (size_t)lrow * 128 + lch * 8;
        const float* dl_src = DL + (size_t)(b * (SEQ / 32)) * EI + h * 128 + (tid & 127);
        const unsigned st_qk = offb(lrow, lch), st_v = 16384u + offb(lrow, lch);
        const unsigned rq = (unsigned)(g >> 1);
        const unsigned rrow = (unsigned)c;
        const unsigned swz = ((rrow & 3u) << 2) | ((rrow >> 2) & 3u);
        const unsigned rowb = (unsigned)kh * 8192u + 256u * rrow + (unsigned)(g & 1) * 8u;
        const unsigned trow = 4u * (unsigned)g + ((unsigned)c >> 2), tp = (unsigned)c & 3u;
        const unsigned tr_v0 = 16384u + offb(trow, 2u * (unsigned)(2 * vq) + (tp >> 1)) + 8u * (tp & 1u);
        const unsigned tr_v1 = 16384u + offb(trow, 2u * (unsigned)(2 * vq + 1) + (tp >> 1)) + 8u * (tp & 1u);
        unsigned tr_k[4];
#pragma unroll
        for (int kt = 0; kt < 4; ++kt) tr_k[kt] = (unsigned)kh * 8192u + offb(trow, 2u * (unsigned)(4 + kt) + (tp >> 1)) + 8u * (tp & 1u);
        bf16_t* o_dst = QE + hbase + (size_t)c * 128 + vq * 32 + g * 4;
        const unsigned xchw = (unsigned)SCAN_XCH + (unsigned)kh * 16384u + (unsigned)vq * 4096u + (unsigned)lane * 16u;
        const unsigned xchr = (unsigned)SCAN_XCH + (unsigned)vq * 4096u + (unsigned)(kh * 2) * 1024u + (unsigned)lane * 16u;
        const unsigned dlo = 24576u + (unsigned)(kh * 64 + 4 * g) * 4u;

        f32x4 S[2][4];
#pragma unroll
        for (int vt = 0; vt < 2; ++vt) {
#pragma unroll
            for (int kt = 0; kt < 4; ++kt) S[vt][kt] = (f32x4){0.f, 0.f, 0.f, 0.f};
        }
#define SCAN_CI(s_) (dir ? 127 - ((s_) < 127 ? (s_) : 127) : ((s_) < 127 ? (s_) : 127))
#define SCAN_LOAD(cn_, P0, P1, PV, PD) do { P0 = __builtin_nontemporal_load((const u32x4*)(qk_src + (size_t)(cn_) * 32 * 128)); P1 = __builtin_nontemporal_load((const u32x4*)(qk_src + (size_t)(cn_) * 32 * 128 + 64)); \
            PV = __builtin_nontemporal_load((const u32x4*)(v_src + (size_t)(cn_) * 32 * 128)); if (tid < 128) PD = dl_src[(size_t)(cn_) * EI]; } while (0)
#define SCAN_PUT(bn_, P0, P1, PV, PD) do { *(LAS u32x4*)(lds + (bn_) + st_qk) = P0; *(LAS u32x4*)(lds + (bn_) + 8192u + st_qk) = P1; \
            *(LAS u32x4*)(lds + (bn_) + st_v) = PV; if (tid < 128) *(LAS float*)(lds + (bn_) + 24576u + tid * 4) = PD; } while (0)
        const u32x4 z4 = (u32x4){0u, 0u, 0u, 0u};
        u32x4 p0A = z4, p1A = z4, pvA = z4, p0B = z4, p1B = z4, pvB = z4, p0C = z4, p1C = z4, pvC = z4, p0D = z4, p1D = z4, pvD = z4; float pdA = 0.f, pdB = 0.f, pdC = 0.f, pdD = 0.f;
        {
            SCAN_LOAD(SCAN_CI(0), p0A, p1A, pvA, pdA); SCAN_LOAD(SCAN_CI(1), p0B, p1B, pvB, pdB); SCAN_LOAD(SCAN_CI(2), p0C, p1C, pvC, pdC); SCAN_LOAD(SCAN_CI(3), p0D, p1D, pvD, pdD);
            SCAN_PUT(0u, p0A, p1A, pvA, pdA);
        }
        __syncthreads();
#define SCAN_FLUSH(s_) do { const int cp = SCAN_CI((s_) - 1); const unsigned xo = xchr + (unsigned)(((s_) - 1) & 1) * 32768u; u32x2 wv[2]; \
            _Pragma("unroll") for (int pt = 0; pt < 2; ++pt) { const f32x4 o = *(const LAS f32x4*)(lds + xo + pt * 1024) + *(const LAS f32x4*)(lds + xo + 16384u + pt * 1024); \
                wv[pt].x = cvt_pk_bf16(o[0], o[1]); wv[pt].y = cvt_pk_bf16(o[2], o[3]); } \
            store_pair16(o_dst + (size_t)(cp * 32) * 128 + kh * 16, o_dst + (size_t)(cp * 32 + 16) * 128 + kh * 16, wv[0], wv[1], g); } while (0)
#define SCAN_STEP(s_, BO, BN, P0W, P1W, PVW, PDW, P0L, P1L, PVL, PDL) do { \
            const unsigned bo = (BO), bn = (BN); \
            SCAN_LOAD(SCAN_CI((s_) + 4), P0L, P1L, PVL, PDL); \
            bf16x8 qeB[2][2], kiA[2][2]; \
            _Pragma("unroll") for (int kk = 0; kk < 2; ++kk) { \
                const unsigned ch0 = (unsigned)(4 * kk) | rq, ch1 = ch0 | 2u; \
                const unsigned a0 = bo + rowb + 16u * (ch0 ^ swz), a1 = bo + rowb + 16u * (ch1 ^ swz); \
                const unsigned k0 = bo + rowb + 16u * ((ch0 | 8u) ^ swz), k1 = bo + rowb + 16u * ((ch1 | 8u) ^ swz); \
                _Pragma("unroll") for (int pt = 0; pt < 2; ++pt) { \
                    qeB[pt][kk] = join8(*(const LAS u32x2*)(lds + a0 + pt * 4096), *(const LAS u32x2*)(lds + a1 + pt * 4096)); \
                    kiA[pt][kk] = join8(*(const LAS u32x2*)(lds + k0 + pt * 4096), *(const LAS u32x2*)(lds + k1 + pt * 4096)); } } \
            u32x2 vlo[2], vhi[2], klo[4], khi[4]; \
            { const unsigned av0 = lbase + bo + tr_v0, av1 = lbase + bo + tr_v1, ak0 = lbase + bo + tr_k[0], ak1 = lbase + bo + tr_k[1], ak2 = lbase + bo + tr_k[2], ak3 = lbase + bo + tr_k[3]; \
              asm volatile("ds_read_b64_tr_b16 %0, %12\n\tds_read_b64_tr_b16 %1, %12 offset:4096\n\t" \
                           "ds_read_b64_tr_b16 %2, %13\n\tds_read_b64_tr_b16 %3, %13 offset:4096\n\t" \
                           "ds_read_b64_tr_b16 %4, %14\n\tds_read_b64_tr_b16 %5, %14 offset:4096\n\t" \
                           "ds_read_b64_tr_b16 %6, %15\n\tds_read_b64_tr_b16 %7, %15 offset:4096\n\t" \
                           "ds_read_b64_tr_b16 %8, %16\n\tds_read_b64_tr_b16 %9, %16 offset:4096\n\t" \
                           "ds_read_b64_tr_b16 %10, %17\n\tds_read_b64_tr_b16 %11, %17 offset:4096\n\t" \
                           "s_waitcnt lgkmcnt(0)" \
                           : "=&v"(vlo[0]), "=&v"(vhi[0]), "=&v"(vlo[1]), "=&v"(vhi[1]), "=&v"(klo[0]), "=&v"(khi[0]), "=&v"(klo[1]), "=&v"(khi[1]), "=&v"(klo[2]), "=&v"(khi[2]), "=&v"(klo[3]), "=&v"(khi[3]) \
                           : "v"(av0), "v"(av1), "v"(ak0), "v"(ak1), "v"(ak2), "v"(ak3) : "memory"); } \
            bf16x8 ATp[2]; \
            { f32x4 AT[2][2]; \
              _Pragma("unroll") for (int ut = 0; ut < 2; ++ut) _Pragma("unroll") for (int pt = 0; pt < 2; ++pt) { \
                f32x4 z = (f32x4){0.f, 0.f, 0.f, 0.f}; \
                z = __builtin_amdgcn_mfma_f32_16x16x32_bf16(kiA[ut][0], qeB[pt][0], z, 0, 0, 0); \
                z = __builtin_amdgcn_mfma_f32_16x16x32_bf16(kiA[ut][1], qeB[pt][1], z, 0, 0, 0); \
                _Pragma("unroll") for (int i = 0; i < 4; ++i) { const int uu = 16 * ut + 4 * g + i, pp = 16 * pt + c; const bool keep = dir ? (uu >= pp) : (uu <= pp); z[i] = keep ? z[i] : 0.f; } \
                AT[ut][pt] = z; } \
              ATp[0] = pack8(AT[0][0], AT[1][0]); ATp[1] = pack8(AT[0][1], AT[1][1]); } \
            _Pragma("unroll") for (int vt = 0; vt < 2; ++vt) { \
                const bf16x8 vT = join8(vlo[vt], vhi[vt]); \
                const bf16x8 Sf0 = pack8(S[vt][0], S[vt][1]), Sf1 = pack8(S[vt][2], S[vt][3]); \
                _Pragma("unroll") for (int pt = 0; pt < 2; ++pt) { \
                    f32x4 o = (f32x4){0.f, 0.f, 0.f, 0.f}; \
                    o = __builtin_amdgcn_mfma_f32_16x16x32_bf16(Sf0, qeB[pt][0], o, 0, 0, 0); \
                    o = __builtin_amdgcn_mfma_f32_16x16x32_bf16(Sf1, qeB[pt][1], o, 0, 0, 0); \
                    o = __builtin_amdgcn_mfma_f32_16x16x32_bf16(vT, ATp[pt], o, 0, 0, 0); \
                    *(LAS f32x4*)(lds + xchw + (unsigned)((s_) & 1) * 32768u + (vt * 2 + pt) * 1024) = o; } \
                _Pragma("unroll") for (int kt = 0; kt < 4; ++kt) { \
                    S[vt][kt] = __builtin_amdgcn_mfma_f32_16x16x32_bf16(join8(klo[kt], khi[kt]), vT, S[vt][kt], 0, 0, 0); \
                    S[vt][kt] = S[vt][kt] * *(const LAS f32x4*)(lds + bo + dlo + 64 * kt); } } \
            if ((s_) > 0) SCAN_FLUSH(s_);     \
            SCAN_PUT(bn, P0W, P1W, PVW, PDW); \
            __syncthreads(); } while (0)
        for (int s = 0; s < 128; s += 4) {
            SCAN_STEP(s, 0u, (unsigned)SCAN_BUF, p0B, p1B, pvB, pdB, p0A, p1A, pvA, pdA);
            SCAN_STEP(s + 1, (unsigned)SCAN_BUF, 0u, p0C, p1C, pvC, pdC, p0B, p1B, pvB, pdB);
            SCAN_STEP(s + 2, 0u, (unsigned)SCAN_BUF, p0D, p1D, pvD, pdD, p0C, p1C, pvC, pdC);
            SCAN_STEP(s + 3, (unsigned)SCAN_BUF, 0u, p0A, p1A, pvA, pdA, p0D, p1D, pvD, pdD);
        }
        SCAN_FLUSH(128);
        __syncthreads();
#undef SCAN_STEP
#undef SCAN_FLUSH
#undef SCAN_PUT
#undef SCAN_LOAD
#undef SCAN_CI
    }
}

__device__ __forceinline__ void combine_phase(const bf16_t* __restrict__ OF, const bf16_t* __restrict__ OB, const bf16_t* __restrict__ SZ, bf16_t* __restrict__ ON, const float* __restrict__ nw) {
    const int nthreads = gridDim.x * 512;
    for (int task0 = blockIdx.x * 512 + threadIdx.x; task0 < MH * 256; task0 += 2 * nthreads) {
        u32x4 a0[2], b0[2], zz[2];
#pragma unroll
        for (int q = 0; q < 2; ++q) {
            const int task = task0 + q * nthreads; const int cv = task & 15, tin = (task >> 4) & (SEQ - 1), hh = (task >> 16) & 15, bb = task >> 20;
            const size_t off = (size_t)bb * ((size_t)EI * SEQ) + (size_t)hh * ((size_t)SEQ * 128) + (size_t)tin * 128 + cv * 8;
            a0[q] = *(const u32x4*)(OF + off); b0[q] = *(const u32x4*)(OB + off);
            zz[q] = *(const u32x4*)(SZ + (size_t)(bb * SEQ + tin) * EI + hh * 128 + cv * 8);
        }
#pragma unroll
        for (int q = 0; q < 2; ++q) {
            const int task = task0 + q * nthreads; const int cv = task & 15, tin = (task >> 4) & (SEQ - 1), hh = (task >> 16) & 15, bb = task >> 20, t = bb * SEQ + tin;
            float o[8]; float ss = 0.f;
#pragma unroll
            for (int i = 0; i < 4; ++i) {
                o[2 * i] = bflo(a0[q][i]) + bflo(b0[q][i]);
                o[2 * i + 1] = bfhi(a0[q][i]) + bfhi(b0[q][i]);
                ss += o[2 * i] * o[2 * i] + o[2 * i + 1] * o[2 * i + 1];
            }
            ss += __shfl_xor(ss, 1); ss += __shfl_xor(ss, 2); ss += __shfl_xor(ss, 4); ss += __shfl_xor(ss, 8);
            const float r = rsqrtf(ss * (1.0f / 128.0f) + EPSV);
            const int e = hh * 128 + cv * 8;
            const f32x4 w0 = *(const f32x4*)(nw + e), w1 = *(const f32x4*)(nw + e + 4);
            u32x4 w; w.x = cvt_pk_bf16(o[0] * r * w0[0] * bflo(zz[q].x), o[1] * r * w0[1] * bfhi(zz[q].x)); w.y = cvt_pk_bf16(o[2] * r * w0[2] * bflo(zz[q].y), o[3] * r * w0[3] * bfhi(zz[q].y));
            w.z = cvt_pk_bf16(o[4] * r * w1[0] * bflo(zz[q].z), o[5] * r * w1[1] * bfhi(zz[q].z)); w.w = cvt_pk_bf16(o[6] * r * w1[2] * bflo(zz[q].w), o[7] * r * w1[3] * bfhi(zz[q].w));
            *(u32x4*)(ON + (size_t)t * EI + e) = w;
        }
    }
}

__device__ __forceinline__ void final_norm(const bf16_t* __restrict__ xb, float* __restrict__ out, const float* __restrict__ fw) {
    const int lane = threadIdx.x & 63, gw = blockIdx.x * 8 + (threadIdx.x >> 6), nw_ = gridDim.x * 8;
    f32x4 wv[4];
#pragma unroll
    for (int i = 0; i < 4; ++i) wv[i] = *(const f32x4*)(fw + i * 256 + lane * 4);
    for (int row = gw; row < MT; row += 2 * nw_) {
        u32x2 v[2][4];
#pragma unroll
        for (int q = 0; q < 2; ++q)
#pragma unroll
            for (int i = 0; i < 4; ++i) v[q][i] = *(const u32x2*)(xb + (size_t)(row + q * nw_) * DM + i * 256 + lane * 4);
#pragma unroll
        for (int q = 0; q < 2; ++q) {
            f32x4 f[4]; float ss = 0.f;
#pragma unroll
            for (int i = 0; i < 4; ++i) { f[i] = (f32x4){bflo(v[q][i].x), bfhi(v[q][i].x), bflo(v[q][i].y), bfhi(v[q][i].y)}; ss += (f[i][0] * f[i][0] + f[i][1] * f[i][1]) + (f[i][2] * f[i][2] + f[i][3] * f[i][3]); }
#pragma unroll
            for (int o = 32; o >= 1; o >>= 1) ss += __shfl_xor(ss, o);
            const float r = rsqrtf(ss * (1.0f / DM) + EPSV);
#pragma unroll
            for (int i = 0; i < 4; ++i) *(f32x4*)(out + (size_t)(row + q * nw_) * DM + i * 256 + lane * 4) = f[i] * r * wv[i];
        }
    }
}


#define XB_TMO      128
#define XB_XCNT(j)  (256  + 64 * (j))
#define XB_XSUB(j)  (1280 + 64 * (j))
#define XB_XGEN(j)  (2304 + 64 * (j))
#define XB_TOP      3328
#define XB_TOPGEN   3392
#define XCD_BAR_WORDS 3456
#define XB_SPIN_CAP (1u << 18)
__device__ __forceinline__ unsigned xb_ld(unsigned* p)              { return __hip_atomic_load(p, __ATOMIC_RELAXED, __HIP_MEMORY_SCOPE_AGENT); }
__device__ __forceinline__ unsigned xb_add(unsigned* p, unsigned v) { return __hip_atomic_fetch_add(p, v, __ATOMIC_RELAXED, __HIP_MEMORY_SCOPE_AGENT); }
__device__ __forceinline__ unsigned xb_xcc_id() { return (unsigned)__builtin_amdgcn_s_getreg((3 << 11) | 20) & 0xFu; }
#define XB_SPIN(cond, bar) do { unsigned _sp = 0; while (cond) { __builtin_amdgcn_s_sleep(1); \
    if ((++_sp & 255u) == 0u) { if (xb_ld(&(bar)[XB_TMO])) break; if (_sp > XB_SPIN_CAP) { atomicAdd(&(bar)[XB_TMO], 1u); break; } } } } while (0)
struct XcdBarrier { unsigned* bar; unsigned x; volatile LAS unsigned* st; };
__device__ __forceinline__ XcdBarrier xcd_barrier_post(unsigned* bar, volatile LAS unsigned* st) {
    XcdBarrier b; b.bar = bar; b.x = xb_xcc_id(); b.st = st;
    if (threadIdx.x == 0) (void)xb_add(&bar[XB_XCNT(b.x)], 1u);
    return b;
}
__device__ __forceinline__ void xcd_barrier_complete(unsigned* bar, unsigned x, unsigned& nloc, unsigned& nx) {
    const unsigned G = gridDim.x * gridDim.y * gridDim.z;
    unsigned sum, cnt, mine, sp = 0u;
    for (;;) {
        sum = 0u; cnt = 0u; mine = 0u;
#pragma unroll
        for (unsigned j = 0; j < 16; ++j) { const unsigned c = xb_ld(&bar[XB_XCNT(j)]); sum += c; cnt += (c > 0u) ? 1u : 0u; mine = (j == x) ? c : mine; }
        if (sum == G) break;
        __builtin_amdgcn_s_sleep(1);
        if ((++sp & 255u) == 0u) { if (xb_ld(&bar[XB_TMO])) break; if (sp > XB_SPIN_CAP) { atomicAdd(&bar[XB_TMO], 1u); break; } }
    }
    nloc = mine > 0u ? mine : 1u; nx = cnt > 0u ? cnt : 1u;
}
__device__ __forceinline__ void xcd_barrier(const XcdBarrier& b) {
    asm volatile("s_waitcnt vmcnt(0)" ::: "memory");
    __syncthreads();
    if (threadIdx.x == 0) {
        unsigned* bar = b.bar;
        __builtin_amdgcn_s_waitcnt(0);
        unsigned nloc = b.st[0], nx = b.st[1];
        if (nloc == 0u) { xcd_barrier_complete(bar, b.x, nloc, nx); b.st[0] = nloc; b.st[1] = nx; }
        const unsigned old = xb_add(&bar[XB_XSUB(b.x)], 1u);
        const unsigned gen = old / nloc;
        if (old + 1u == (gen + 1u) * nloc) {
            __builtin_amdgcn_fence(__ATOMIC_RELEASE, "agent");
            asm volatile("s_waitcnt vmcnt(0)" ::: "memory");
            const unsigned og = xb_add(&bar[XB_TOP], 1u);
            const unsigned tg = og / nx;
            if (og + 1u == (tg + 1u) * nx) xb_add(&bar[XB_TOPGEN], 1u);
            else XB_SPIN(xb_ld(&bar[XB_TOPGEN]) == tg, bar);
            __builtin_amdgcn_fence(__ATOMIC_ACQUIRE, "agent");
            xb_add(&bar[XB_XGEN(b.x)], 1u);
            asm volatile("s_waitcnt vmcnt(0)" ::: "memory");
        } else {
            XB_SPIN(xb_ld(&bar[XB_XGEN(b.x)]) == gen, bar);
            __builtin_amdgcn_fence(__ATOMIC_ACQUIRE, "agent");
            asm volatile("s_waitcnt vmcnt(0)" ::: "memory");
        }
    }
    __syncthreads();
}

__device__ __forceinline__ void grid_barrier(cg::grid_group& grid) {
    asm volatile("s_waitcnt vmcnt(0) lgkmcnt(0)" ::: "memory");
    grid.sync();
    __builtin_amdgcn_fence(__ATOMIC_ACQUIRE, "agent");
    asm volatile("s_waitcnt vmcnt(0)" ::: "memory");
}
__global__ void __launch_bounds__(512, 2) fwd_megakernel(Params P) {
    extern __shared__ __attribute__((aligned(16))) unsigned char lds_raw[];
    LAS unsigned char* lds = (LAS unsigned char*)lds_raw;
    cg::grid_group grid = cg::this_grid();
    const int G = gridDim.x, bid = blockIdx.x;
    unsigned char* ws = P.ws;
    bf16_t* xb = (bf16_t*)(ws + WS_XB); float* rs = (float*)(ws + WS_RS);

    volatile LAS unsigned* xbst = (volatile LAS unsigned*)(lds + pg8::STAGE_BYTES);
    if (threadIdx.x == 0) { xbst[0] = 0u; xbst[1] = 0u; xbst[2] = 0u; xbst[3] = 0u; }
    __syncthreads();
    const XcdBarrier xbar = xcd_barrier_post((unsigned*)(ws + WS_BAR), xbst);
    prologue(P, lds);
    if (P.never) grid_barrier(grid);
    xcd_barrier(xbar);

#pragma nounroll
    for (int layer = 0; layer < DBG_LAYERS; ++layer) {
        const int j = layer >> 1;
        if ((layer & 1) == 0) {
            bf16_t* VE = (bf16_t*)(ws + WS_CV); bf16_t* GE = (bf16_t*)(ws + WS_CV + 16 * MiB); bf16_t* Gb = (bf16_t*)(ws + WS_CG);
            {
                pg8::Gemm g{xb, (const bf16_t*)(ws + WS_WCIN) + (size_t)j * 8192 * DM, MT, 8192, DM}; pg8::StaticOrder S; S.init(MT, 8192, G, bid);
                const RCtx rc = fill_row_scales(lds, S, rs, 0);
                EpiConv1 E{rs, Gb, VE, GE, P.conv_kernel + (size_t)j * 3 * EI, rc, (bf16_t*)P.out};
                pg8::gemm_phase<EpiConv1>(lds, g, S, E);
            }
            xcd_barrier(xbar);
            conv_fix(Gb, (bf16_t*)P.out, VE, GE, P.conv_kernel + (size_t)j * 3 * EI);
            xcd_barrier(xbar);
            {
                pg8::Gemm g{Gb, (const bf16_t*)(ws + WS_WCOUT) + (size_t)j * DM * EI, MH, DM, EI}; pg8::StaticOrder S; S.init(MH, DM, G, bid);
                EpiRes E{xb, rs, 0};
                pg8::gemm_phase<EpiRes>(lds, g, S, E);
            }
            xcd_barrier(xbar);
        } else {
            bf16_t* QEF = (bf16_t*)(ws + WS_QEF); bf16_t* KIF = (bf16_t*)(ws + WS_KIF); bf16_t* QEB = (bf16_t*)(ws + WS_QEB); bf16_t* KIB = (bf16_t*)(ws + WS_KIB); bf16_t* VV = (bf16_t*)(ws + WS_VV);
            float* DLF = (float*)(ws + WS_DLF); float* DLB = (float*)(ws + WS_DLB);
            bf16_t* Y0 = (bf16_t*)P.out + (size_t)MH * EI;
            const bf16_t* Win = (const bf16_t*)(ws + WS_WHIN) + (size_t)j * 10240 * DM;
#pragma nounroll
            for (int half = 0; half < 2; ++half) {
                const int rb = half * MH;
                {
                    pg8::Gemm g{xb + (size_t)rb * DM, Win, MH, 8192, DM}; pg8::StaticOrder S; S.init(MH, 8192, G, bid);
                    const RCtx rc = fill_row_scales(lds, S, rs, rb);
                    EpiH1 E{rs, P.hgrn_lb, j, rb, QEF, KIF, QEB, KIB, VV, DLF, DLB, (bf16_t*)P.out, rc};
                    pg8::gemm_phase<EpiH1>(lds, g, S, E);
                }
                xcd_barrier(xbar);
                if (bid < 128 || G < 256) {
                    scan_phase(lds, QEF, KIF, QEB, KIB, VV, DLF, DLB);
                }
                if (bid >= 128 || G < 256) {
                    const int Gz = (G < 256) ? G : G - 128, cz = (G < 256) ? bid : bid - 128;
                    pg8::Gemm g{xb + (size_t)rb * DM, Win + (size_t)8192 * DM, MH, EI, DM}; pg8::StaticOrder S; S.init(MH, EI, Gz, cz, (G < 256) ? 8 : 4);
                    const RCtx rc = fill_row_scales(lds, S, rs, rb);
                    EpiSZ E{rs, rb, (bf16_t*)P.out, rc};
                    pg8::gemm_phase<EpiSZ>(lds, g, S, E);
                    if (half == 0) {
                        pg8::Gemm g2{(const bf16_t*)P.out + (size_t)MH * EI, (const bf16_t*)(ws + WS_WCOUT) + (size_t)j * DM * EI, MH, DM, EI}; pg8::StaticOrder S2; S2.init(MH, DM, Gz, cz, (G < 256) ? 8 : 4);
                        EpiRes E2{xb, rs, MH};
                        pg8::gemm_phase<EpiRes>(lds, g2, S2, E2);
                    }
                    if (half == 1) {
                        pg8::Gemm g2{Y0, (const bf16_t*)(ws + WS_WHOUT) + (size_t)j * DM * EI, MH, DM, EI}; pg8::StaticOrder S2; S2.init(MH, DM, Gz, cz, (G < 256) ? 8 : 4);
                        EpiRes E2{xb, rs, 0};
                        pg8::gemm_phase<EpiRes>(lds, g2, S2, E2);
                    }
                }
                xcd_barrier(xbar);
                combine_phase(QEF, QEB, (const bf16_t*)P.out, (half == 0) ? Y0 : VV, P.hgrn_norm_w + (size_t)j * EI);
                xcd_barrier(xbar);
                if (half == 1) {
                    pg8::Gemm g{VV, (const bf16_t*)(ws + WS_WHOUT) + (size_t)j * DM * EI, MH, DM, EI}; pg8::StaticOrder S; S.init(MH, DM, G, bid);
                    EpiRes E{xb, rs, rb};
                    pg8::gemm_phase<EpiRes>(lds, g, S, E);
                    xcd_barrier(xbar);
                }
            }
        }
    }
    if (DBG_LAYERS == 0) { const size_t n = (size_t)MT * DM; for (size_t i = (size_t)blockIdx.x * 512 + threadIdx.x; i < n; i += (size_t)gridDim.x * 512) P.out[i] = P.x[i]; xcd_barrier(xbar); }
    final_norm(xb, P.out, P.final_norm_w);
}

extern "C" void kernel_launch(void* const* d_in, const int* in_sizes, int n_in, void* d_out, int out_size, void* d_ws, size_t ws_size, hipStream_t stream) {
    constexpr size_t kDynLds = pg8::STAGE_BYTES + 16 + 2048;
    static int grid_blocks = 0;
    if (!grid_blocks) {
        if (ws_size < WS_END) { fprintf(stderr, "kernel_launch: workspace too small: %zu < %zu\n", ws_size, (size_t)WS_END); grid_blocks = -1; return; }
        int dev = 0, cus = 0, per_cu = 0;
        hipGetDevice(&dev);
        hipDeviceGetAttribute(&cus, hipDeviceAttributeMultiprocessorCount, dev);
        if (hipFuncSetAttribute((const void*)fwd_megakernel, hipFuncAttributeMaxDynamicSharedMemorySize, (int)kDynLds) != hipSuccess) { fprintf(stderr, "kernel_launch: hipFuncSetAttribute failed\n"); grid_blocks = -1; return; }
        hipOccupancyMaxActiveBlocksPerMultiprocessor(&per_cu, (const void*)fwd_megakernel, 512, kDynLds);
        if (per_cu < 1) per_cu = 1;
        grid_blocks = cus * per_cu;
        if (grid_blocks > 256) grid_blocks = 256;
        (void)hipGetLastError();
    }
    if (grid_blocks < 0) return;
    if (hipMemsetAsync((char*)d_ws + WS_BAR, 0, 16384, stream) != hipSuccess) { fprintf(stderr, "kernel_launch: memset of barrier words failed\n"); return; }
    Params p{};
    p.x = (const float*)d_in[0]; p.norm_w = (const float*)d_in[1]; p.final_norm_w = (const float*)d_in[2]; p.conv_w_in = (const float*)d_in[3]; p.conv_kernel = (const float*)d_in[4];
    p.conv_w_out = (const float*)d_in[5]; p.hgrn_w_in = (const float*)d_in[6]; p.hgrn_lb = (const float*)d_in[7]; p.hgrn_norm_w = (const float*)d_in[8]; p.hgrn_w_out = (const float*)d_in[9];
    p.out = (float*)d_out; p.ws = (unsigned char*)d_ws;
    void* args[] = {&p};
    hipError_t e = hipLaunchCooperativeKernel((void*)fwd_megakernel, dim3(grid_blocks), dim3(512), args, kDynLds, stream);
    if (e != hipSuccess) fprintf(stderr, "cooperative launch failed: %s (grid %d)\n", hipGetErrorString(e), grid_blocks);
}
```

```cpp
#include <hip/hip_runtime.h>
#include <hip/hip_cooperative_groups.h>
#include <cstdio>
namespace cg = cooperative_groups;
#ifndef DBG_LAYERS
#define DBG_LAYERS 4
#endif

#define LAS __attribute__((address_space(3)))
typedef unsigned short bf16_t;
typedef short bf16x8 __attribute__((ext_vector_type(8)));
typedef short bf16x4 __attribute__((ext_vector_type(4)));
typedef float f32x4 __attribute__((ext_vector_type(4)));
typedef unsigned u32x4 __attribute__((ext_vector_type(4)));
typedef unsigned u32x2 __attribute__((ext_vector_type(2)));

constexpr int DM = 1024, EI = 2048, SEQ = 4096, NB = 8, MT = NB * SEQ  , MH = MT / 2;
constexpr float EPSV = 1e-6f;
constexpr size_t MiB = 1024ull * 1024ull;
constexpr size_t WS_XB = 0;
constexpr size_t WS_WCIN = WS_XB + 64 * MiB;
constexpr size_t WS_WCOUT = WS_WCIN + 32 * MiB;
constexpr size_t WS_WHIN = WS_WCOUT + 8 * MiB;
constexpr size_t WS_WHOUT = WS_WHIN + 40 * MiB;
constexpr size_t WS_RS = WS_WHOUT + 8 * MiB;
constexpr size_t WS_BIG = WS_RS + 2 * MiB;
constexpr size_t WS_CV = WS_BIG;
constexpr size_t WS_CG = WS_BIG + 128 * MiB;
constexpr size_t WS_QEF = WS_BIG;
constexpr size_t WS_KIF = WS_BIG + 64 * MiB;
constexpr size_t WS_QEB = WS_BIG + 128 * MiB;
constexpr size_t WS_KIB = WS_BIG + 192 * MiB;
constexpr size_t WS_VV = WS_BIG + 256 * MiB;
constexpr size_t WS_DLF = WS_BIG + 320 * MiB;
constexpr size_t WS_DLB = WS_BIG + 324 * MiB;
constexpr size_t WS_BAR = WS_BIG + 328 * MiB;
constexpr size_t WS_END = WS_BAR + 16384;

typedef __bf16 bf16v2_t __attribute__((ext_vector_type(2)));
typedef float f32x2_t __attribute__((ext_vector_type(2)));
__device__ __forceinline__ unsigned cvt_pk_bf16(float lo, float hi) { const f32x2_t v = {lo, hi}; return __builtin_bit_cast(unsigned, __builtin_convertvector(v, bf16v2_t)); }
__device__ __forceinline__ float bflo(unsigned w) { return __uint_as_float(w << 16); }
__device__ __forceinline__ float bfhi(unsigned w) { return __uint_as_float(w & 0xffff0000u); }
__device__ __forceinline__ float fast_exp2(float x) { return __builtin_amdgcn_exp2f(x); }
__device__ __forceinline__ float fast_exp(float x) { return __builtin_amdgcn_exp2f(x * 1.44269504089f); }
__device__ __forceinline__ float fast_rcp(float x) { return __builtin_amdgcn_rcpf(x); }
template <int CTRL> __device__ __forceinline__ float dppf(float x) { return __int_as_float(__builtin_amdgcn_update_dpp(0, __float_as_int(x), CTRL, 0xf, 0xf, false)); }
__device__ __forceinline__ float row_prefix16(float x) { x += dppf<0x111>(x); x += dppf<0x112>(x); x += dppf<0x114>(x); x += dppf<0x118>(x); return x; }
template <int CTRL> __device__ __forceinline__ float dppf1(float x) { return __int_as_float(__builtin_amdgcn_update_dpp(0x3f800000, __float_as_int(x), CTRL, 0xf, 0xf, false)); }
__device__ __forceinline__ float row_prefprod16(float x) { x *= dppf1<0x111>(x); x *= dppf1<0x112>(x); x *= dppf1<0x114>(x); x *= dppf1<0x118>(x); return x; }
__device__ __forceinline__ float row_sufprod16(float x) { x *= dppf1<0x101>(x); x *= dppf1<0x102>(x); x *= dppf1<0x104>(x); x *= dppf1<0x108>(x); return x; }
__device__ __forceinline__ float row_suffix16(float x) { x += dppf<0x101>(x); x += dppf<0x102>(x); x += dppf<0x104>(x); x += dppf<0x108>(x); return x; }

namespace pg8 {
constexpr int BM = 256, BK = 64, HALF = 128, HTB = HALF * BK * 2, STAGE_BYTES = 8 * HTB, NXCD = 8, WGM = 8;
__host__ __device__ __forceinline__ int lds_byte(int r, int c) { const int st = (r >> 4) * 2 + (c >> 5), rr = r & 15, cc = c & 31, ob = rr * 64 + cc * 2; return st * 1024 + (ob ^ (((ob >> 9) & 1) << 5)); }
__host__ __device__ __forceinline__ void stage_rc(int b, int& R, int& C) { const int st = b / 1024, sb = b % 1024, swz = sb ^ (((sb >> 9) & 1) << 5); R = (st >> 1) * 16 + swz / 64; C = (st & 1) * 32 + (swz % 64) / 2; }
struct Unit { int pm, pn; };
struct Gemm { const bf16_t* A; const bf16_t* Bt; int M, N, K; };
struct StaticOrder {
    int nM, nN, nwg, G, c, wgm;
    __host__ __device__ void init(int M, int N, int G_, int c_, int wgm_ = WGM) { nM = M / BM; nN = N / BM; nwg = nM * nN; G = G_; c = c_; wgm = wgm_; }
    __host__ __device__ bool next(int i, Unit& u) const {
        const long L = (long)i * G + c; if (L >= nwg) return false;
        int wgid = (int)L; { const int q = nwg / NXCD, r = nwg % NXCD, xcd = wgid % NXCD, off = wgid / NXCD; wgid = (xcd < r ? xcd * (q + 1) : r * (q + 1) + (xcd - r) * q) + off; }
        const int nig = wgm * nN, gid = wgid / nig, fm = gid * wgm, gsz = (nM - fm) < wgm ? (nM - fm) : wgm;
        u.pm = fm + ((wgid % nig) % gsz); u.pn = (wgid % nig) / gsz; return true;
    }
};
template <class Epi>
__device__ __forceinline__ void gemm_phase(LAS unsigned char* lds, const Gemm g, const StaticOrder& S, const Epi& E) {
    int tid = threadIdx.x; asm volatile("" : "+v"(tid));
    const int wid = __builtin_amdgcn_readfirstlane(tid >> 6), lane = tid & 63, wr = wid >> 2, wc = wid & 3, fr = lane & 15, fq = lane >> 4;
    const int K = g.K, nt = K / BK;
    unsigned voffA[2];
#pragma unroll
    for (int i = 0; i < 2; ++i) { int R, C; stage_rc(tid * 16 + i * 8192, R, C); voffA[i] = (unsigned)(R * K + C) * 2u; }
    const size_t kstep = (size_t)(BK * 2);
    const size_t hstep = (size_t)HALF * K * 2;
    const size_t tstep = 2 * hstep;
    const unsigned ldsw = (unsigned)wid * 1024u;
    const int aoff = lds_byte(wr * 64 + fr, fq * 8), boff = lds_byte(wc * 32 + fr, fq * 8);
#define PG8_SA(b, h) (((b) * 2 + (h)) * HTB)
#define PG8_SB(b, h) ((4 + (b) * 2 + (h)) * HTB)
#define PG8_STAGE(bufoff, gbase, voff) do { _Pragma("unroll") for (int _i = 0; _i < 2; ++_i) \
        __builtin_amdgcn_global_load_lds((const unsigned*)((const char*)(gbase) + (voff)[_i]), (LAS unsigned*)(lds + (bufoff) + ldsw + _i * 8192), 16, 0, 0); } while (0)
#define PG8_LDA(dst, b, h) do { _Pragma("unroll") for (int m = 0; m < 4; ++m) _Pragma("unroll") for (int k = 0; k < 2; ++k) dst[m][k] = *(const LAS bf16x8*)(lds + PG8_SA(b, h) + aoff + m * 2048 + k * 1024); } while (0)
#define PG8_LDB(dst, b, h) do { _Pragma("unroll") for (int n = 0; n < 2; ++n) _Pragma("unroll") for (int k = 0; k < 2; ++k) dst[n][k] = *(const LAS bf16x8*)(lds + PG8_SB(b, h) + boff + n * 2048 + k * 1024); } while (0)
#define PG8_MMA(ai, bj, At, Bt) do { __builtin_amdgcn_s_setprio(1); _Pragma("unroll") for (int m = 0; m < 4; ++m) _Pragma("unroll") for (int n = 0; n < 2; ++n) _Pragma("unroll") for (int k = 0; k < 2; ++k) \
        acc[ai][bj][m][n] = __builtin_amdgcn_mfma_f32_16x16x32_bf16(Bt[n][k], At[m][k], acc[ai][bj][m][n], 0, 0, 0); __builtin_amdgcn_s_setprio(0); } while (0)
#define PG8_WAIT_V(n) asm volatile("s_waitcnt vmcnt(" #n ")" ::: "memory")
#define PG8_WAIT_L(n) asm volatile("s_waitcnt lgkmcnt(" #n ")" ::: "memory")
#define PG8_BAR __builtin_amdgcn_s_barrier()
#define PG8_SCHED __builtin_amdgcn_sched_barrier(0)
    Unit cur, nxt; int ui = 0;
    if (!S.next(0, cur)) return;
    f32x4 acc[2][2][4][2];
#pragma unroll
    for (int a = 0; a < 2; ++a)
#pragma unroll
        for (int b = 0; b < 2; ++b)
#pragma unroll
            for (int m = 0; m < 4; ++m)
#pragma unroll
                for (int n = 0; n < 2; ++n) acc[a][b][m][n] = (f32x4){0.f, 0.f, 0.f, 0.f};
    bf16x8 At[4][2], B0[2][2], B1[2][2];
    const char* cA = (const char*)g.A + (size_t)cur.pm * tstep; const char* cB = (const char*)g.Bt + (size_t)cur.pn * tstep;
    PG8_STAGE(PG8_SB(0, 0), cB, voffA); PG8_STAGE(PG8_SB(0, 1), cB + hstep, voffA); PG8_STAGE(PG8_SA(0, 0), cA, voffA); PG8_STAGE(PG8_SA(0, 1), cA + hstep, voffA);
    if (wr == 1) PG8_BAR;
    PG8_WAIT_V(2); PG8_BAR;
    PG8_STAGE(PG8_SB(1, 0), cB + kstep, voffA); PG8_STAGE(PG8_SA(1, 0), cA + kstep, voffA); PG8_STAGE(PG8_SB(1, 1), cB + hstep + kstep, voffA);
    PG8_WAIT_V(6); PG8_BAR;
    for (;;) {
        const bool has_next = S.next(ui + 1, nxt);
        const char* nA = has_next ? (const char*)g.A + (size_t)nxt.pm * tstep : cA; const char* nB = has_next ? (const char*)g.Bt + (size_t)nxt.pn * tstep : cB;
        for (int t = 0; t < nt; t += 2) {
            const bool last = (t == nt - 2);
            const char* a1 = cA + (size_t)(t + 1) * kstep;
            const char* a2 = last ? nA : cA + (size_t)(t + 2) * kstep; const char* b2 = last ? nB : cB + (size_t)(t + 2) * kstep;
            const char* a3 = a2 + kstep; const char* b3 = b2 + kstep;
            PG8_LDB(B0, 0, 0); PG8_LDB(B1, 0, 1); PG8_SCHED; PG8_LDA(At, 0, 0); PG8_STAGE(PG8_SA(1, 1), a1 + hstep, voffA);
            PG8_WAIT_V(8); PG8_WAIT_L(0); PG8_BAR; PG8_MMA(0, 0, At, B0); PG8_MMA(0, 1, At, B1); PG8_BAR; PG8_SCHED;
            PG8_LDA(At, 0, 1); PG8_STAGE(PG8_SB(0, 0), b2, voffA); PG8_STAGE(PG8_SB(0, 1), b2 + hstep, voffA); PG8_STAGE(PG8_SA(0, 0), a2, voffA);
            PG8_WAIT_V(8); PG8_WAIT_L(0); PG8_BAR; PG8_MMA(1, 0, At, B0); PG8_MMA(1, 1, At, B1); PG8_BAR; PG8_SCHED;
            PG8_LDB(B0, 1, 0); PG8_LDB(B1, 1, 1); PG8_SCHED; PG8_LDA(At, 1, 0); PG8_STAGE(PG8_SA(0, 1), a2 + hstep, voffA);
            PG8_WAIT_V(8); PG8_WAIT_L(0); PG8_BAR; PG8_MMA(0, 0, At, B0); PG8_MMA(0, 1, At, B1); PG8_BAR; PG8_SCHED;
            PG8_LDA(At, 1, 1); PG8_STAGE(PG8_SB(1, 0), b3, voffA); PG8_STAGE(PG8_SB(1, 1), b3 + hstep, voffA); PG8_STAGE(PG8_SA(1, 0), a3, voffA);
            PG8_WAIT_V(8); PG8_WAIT_L(0); PG8_BAR; PG8_MMA(1, 0, At, B0); PG8_MMA(1, 1, At, B1); PG8_BAR; PG8_SCHED;
        }
        if (wr == 0) PG8_BAR;
        E(acc, cur, wr, wc, fr, fq);
        if (!has_next) break;
#pragma unroll
        for (int a = 0; a < 2; ++a)
#pragma unroll
            for (int b = 0; b < 2; ++b)
#pragma unroll
                for (int m = 0; m < 4; ++m)
#pragma unroll
                    for (int n = 0; n < 2; ++n) acc[a][b][m][n] = (f32x4){0.f, 0.f, 0.f, 0.f};
        cur = nxt; cA = nA; cB = nB; ++ui;
        if (wr == 1) PG8_BAR;
    }
    PG8_WAIT_V(0);
    PG8_BAR;
#undef PG8_SA
#undef PG8_SB
#undef PG8_STAGE
#undef PG8_LDA
#undef PG8_LDB
#undef PG8_MMA
#undef PG8_WAIT_V
#undef PG8_WAIT_L
#undef PG8_BAR
#undef PG8_SCHED
}
}

__device__ __forceinline__ float row_rscale(const float* __restrict__ rs, int row, int fq) {
    const float* p = rs + (size_t)(4 * fq) * MT + row;
    float s = (p[0] + p[MT]) + (p[2 * (size_t)MT] + p[3 * (size_t)MT]);
    s += __shfl_xor(s, 16); s += __shfl_xor(s, 32);
    return rsqrtf(s * (1.0f / DM) + EPSV);
}
__device__ __forceinline__ void row_rscale8(const float* __restrict__ rs, int row0, int fq, float (&r)[2][4]) {
    float s[2][4];
#pragma unroll
    for (int ai = 0; ai < 2; ++ai)
#pragma unroll
        for (int m = 0; m < 4; ++m) { const float* p = rs + (size_t)(4 * fq) * MT + row0 + ai * 128 + m * 16; s[ai][m] = (p[0] + p[MT]) + (p[2 * (size_t)MT] + p[3 * (size_t)MT]); }
#pragma unroll
    for (int ai = 0; ai < 2; ++ai)
#pragma unroll
        for (int m = 0; m < 4; ++m) { float t = s[ai][m]; t += __shfl_xor(t, 16); t += __shfl_xor(t, 32); r[ai][m] = rsqrtf(t * (1.0f / DM) + EPSV); }
}

__device__ __forceinline__ void store_pair16(bf16_t* xp, bf16_t* yp, u32x2 x, u32x2 y, int fq) {
    const u32x2 r0 = __builtin_amdgcn_permlane16_swap(x.x, y.x, false, false);
    const u32x2 r1 = __builtin_amdgcn_permlane16_swap(x.y, y.y, false, false);
    u32x4 d; d.x = r0.x; d.y = r1.x; d.z = r0.y; d.w = r1.y;
    bf16_t* p = (fq & 1) ? (yp - 4) : xp;
    *(u32x4*)p = d;
}

struct RCtx { const LAS float* rl; int pmA, pmB; };
__device__ __forceinline__ RCtx fill_row_scales(LAS unsigned char* lds, const pg8::StaticOrder& S, const float* __restrict__ rs, int row_base) {
    RCtx rc; rc.rl = (const LAS float*)(lds + pg8::STAGE_BYTES + 16); rc.pmA = 0; rc.pmB = 0;
    pg8::Unit u0, ul;
    if (S.next(0, u0)) {
        const int nun = (int)(((long)S.nwg - S.c + S.G - 1) / S.G); S.next(nun - 1, ul);
        rc.pmA = u0.pm; rc.pmB = ul.pm;
        const int tid = threadIdx.x, pm = (tid >> 8) ? ul.pm : u0.pm;
        const float* p = rs + (size_t)(row_base + pm * 256 + (tid & 255));
        float s0 = 0.f, s1 = 0.f, s2 = 0.f, s3 = 0.f;
#pragma unroll
        for (int k = 0; k < 4; ++k) { s0 += p[(size_t)(4 * k) * MT]; s1 += p[(size_t)(4 * k + 1) * MT]; s2 += p[(size_t)(4 * k + 2) * MT]; s3 += p[(size_t)(4 * k + 3) * MT]; }
        ((LAS float*)(lds + pg8::STAGE_BYTES + 16))[tid] = rsqrtf(((s0 + s1) + (s2 + s3)) * (1.0f / DM) + EPSV);
    }
    __syncthreads();
    return rc;
}
__device__ __forceinline__ void row_rscale8c(const RCtx& rc, const float* __restrict__ rs, int grow0, int pm, int lr0, int fq, float (&r)[2][4]) {
    if (pm == rc.pmA || pm == rc.pmB) {
        const LAS float* p = rc.rl + ((pm == rc.pmA) ? 0 : 256) + lr0;
#pragma unroll
        for (int ai = 0; ai < 2; ++ai)
#pragma unroll
            for (int m = 0; m < 4; ++m) r[ai][m] = p[ai * 128 + m * 16];
    } else row_rscale8(rs, grow0, fq, r);
}

struct EpiConv1 {
    const float* rs; bf16_t* Y; bf16_t* VE; bf16_t* GE; const float* ck; RCtx rc; bf16_t* Yhi;
    __device__ __forceinline__ void operator()(const f32x4 (&acc)[2][2][4][2], const pg8::Unit& u, int wr, int wc, int fr, int fq) const {
        const int e0 = u.pn * 64 + wc * 16 + fq * 4;
        float rsc[2][4]; row_rscale8c(rc, rs, u.pm * 256 + wr * 64 + fr, u.pm, wr * 64 + fr, fq, rsc);
        const f32x4 k0 = *(const f32x4*)(ck + e0), k1 = *(const f32x4*)(ck + EI + e0), k2 = *(const f32x4*)(ck + 2 * EI + e0);
#pragma unroll
        for (int ai = 0; ai < 2; ++ai) {
            float v[4][4], gg[4][4];
#pragma unroll
            for (int m = 0; m < 4; ++m) {
                const float r = rsc[ai][m];
                const f32x4 b = acc[ai][0][m][0] * r, c = acc[ai][0][m][1] * r, uu = acc[ai][1][m][0] * r, z = acc[ai][1][m][1] * r;
#pragma unroll
                for (int j = 0; j < 4; ++j) { v[m][j] = c[j] * uu[j]; gg[m][j] = b[j] * z[j] * fast_rcp(1.0f + fast_exp(-z[j])); }
            }
            const int blk = u.pm * 4 + ai * 2 + wr;
#pragma unroll
            for (int m = 0; m < 4; ++m) {
                const int row = u.pm * 256 + ai * 128 + wr * 64 + m * 16 + fr;
                float y[4];
#pragma unroll
                for (int j = 0; j < 4; ++j) {
                    const float pown = dppf<0x121>(v[m][j]);
                    const float pup = (m > 0) ? dppf<0x121>(v[m > 0 ? m - 1 : 0][j]) : 0.f;
                    const float nown = dppf<0x12f>(v[m][j]);
                    const float ndn = (m < 3) ? dppf<0x12f>(v[m < 3 ? m + 1 : 3][j]) : 0.f;
                    const float prev = (fr > 0) ? pown : pup, next = (fr < 15) ? nown : ndn;
                    y[j] = gg[m][j] * (k0[j] * prev + k1[j] * v[m][j] + k2[j] * next);
                }
                u32x2 wy; wy.x = cvt_pk_bf16(y[0], y[1]); wy.y = cvt_pk_bf16(y[2], y[3]);
                *(u32x2*)(((u.pm >= MH / 256) ? Yhi : Y) + (size_t)row * EI + e0) = wy;
                if (m == 0 || m == 3) {
                    u32x2 wv, wg; wv.x = cvt_pk_bf16(v[m][0], v[m][1]); wv.y = cvt_pk_bf16(v[m][2], v[m][3]); wg.x = cvt_pk_bf16(gg[m][0], gg[m][1]); wg.y = cvt_pk_bf16(gg[m][2], gg[m][3]);
                    if (m == 0 && fr < 2) *(u32x2*)(VE + ((size_t)blk * 4 + 2 + fr) * EI + e0) = wv;
                    if (m == 3 && fr >= 14) *(u32x2*)(VE + ((size_t)blk * 4 + (fr - 14)) * EI + e0) = wv;
                    if (m == 0 && fr == 0) *(u32x2*)(GE + ((size_t)blk * 2 + 1) * EI + e0) = wg;
                    if (m == 3 && fr == 15) *(u32x2*)(GE + ((size_t)blk * 2 + 0) * EI + e0) = wg;
                }
            }
        }
    }
};
struct EpiRes {
    bf16_t* xb; float* rs; int row_base;
    __device__ __forceinline__ void operator()(const f32x4 (&acc)[2][2][4][2], const pg8::Unit& u, int wr, int wc, int fr, int fq) const {
        bf16_t* base = xb + (size_t)(row_base + u.pm * 256 + wr * 64 + fr) * DM + u.pn * 256 + wc * 32 + fq * 4;
#pragma unroll
        for (int ai = 0; ai < 2; ++ai) {
            u32x2 xr[4][2][2];
#pragma unroll
            for (int m = 0; m < 4; ++m)
#pragma unroll
                for (int bj = 0; bj < 2; ++bj)
#pragma unroll
                    for (int n = 0; n < 2; ++n) xr[m][bj][n] = *(const u32x2*)(base + (size_t)(ai * 128 + m * 16) * DM + bj * 128 + n * 16);
#pragma unroll
            for (int m = 0; m < 4; ++m) {
                const int row = row_base + u.pm * 256 + ai * 128 + wr * 64 + m * 16 + fr;
                float ss = 0.f;
#pragma unroll
                for (int bj = 0; bj < 2; ++bj) {
                    u32x2 wn[2];
#pragma unroll
                    for (int n = 0; n < 2; ++n) {
                        const u32x2 xo = xr[m][bj][n]; const f32x4 a = acc[ai][bj][m][n];
                        const float x0 = bflo(xo.x) + a[0], x1 = bfhi(xo.x) + a[1], x2 = bflo(xo.y) + a[2], x3 = bfhi(xo.y) + a[3];
                        wn[n].x = cvt_pk_bf16(x0, x1); wn[n].y = cvt_pk_bf16(x2, x3);
                        ss += (x0 * x0 + x1 * x1) + (x2 * x2 + x3 * x3);
                    }
                    bf16_t* q = base + (size_t)(ai * 128 + m * 16) * DM + bj * 128;
                    store_pair16(q, q + 16, wn[0], wn[1], fq);
                }
                ss += __shfl_xor(ss, 16); ss += __shfl_xor(ss, 32);
                if (fq == 0) rs[(size_t)(u.pn * 4 + wc) * MT + row] = ss;
            }
        }
    }
};
struct EpiZ {
    const float* rs; bf16_t* ON; int row_base;
    __device__ __forceinline__ void operator()(const f32x4 (&acc)[2][2][4][2], const pg8::Unit& u, int wr, int wc, int fr, int fq) const {
        bf16_t* base = ON + (size_t)(u.pm * 256 + wr * 64 + fr) * EI + u.pn * 256 + wc * 32 + fq * 4;
        float rsc[2][4]; row_rscale8(rs, row_base + u.pm * 256 + wr * 64 + fr, fq, rsc);
#pragma unroll
        for (int ai = 0; ai < 2; ++ai) {
            u32x2 xr[4][2][2];
#pragma unroll
            for (int m = 0; m < 4; ++m)
#pragma unroll
                for (int bj = 0; bj < 2; ++bj)
#pragma unroll
                    for (int n = 0; n < 2; ++n) xr[m][bj][n] = *(const u32x2*)(base + (size_t)(ai * 128 + m * 16) * EI + bj * 128 + n * 16);
#pragma unroll
            for (int m = 0; m < 4; ++m) {
                const float r = rsc[ai][m];
#pragma unroll
                for (int bj = 0; bj < 2; ++bj)
#pragma unroll
                    for (int n = 0; n < 2; ++n) {
                        const u32x2 o = xr[m][bj][n]; const f32x4 z = acc[ai][bj][m][n] * r;
                        const float o0 = bflo(o.x), o1 = bfhi(o.x), o2 = bflo(o.y), o3 = bfhi(o.y);
                        const float y0 = o0 * z[0] * fast_rcp(1.0f + fast_exp(-z[0])), y1 = o1 * z[1] * fast_rcp(1.0f + fast_exp(-z[1]));
                        const float y2 = o2 * z[2] * fast_rcp(1.0f + fast_exp(-z[2])), y3 = o3 * z[3] * fast_rcp(1.0f + fast_exp(-z[3]));
                        u32x2 w; w.x = cvt_pk_bf16(y0, y1); w.y = cvt_pk_bf16(y2, y3);
                        *(u32x2*)(base + (size_t)(ai * 128 + m * 16) * EI + bj * 128 + n * 16) = w;
                    }
            }
        }
    }
};
__device__ __forceinline__ size_t hm_off(int lrow, int e) { return (size_t)(lrow >> 12) * ((size_t)EI * SEQ) + (size_t)(e >> 7) * ((size_t)SEQ * 128) + (size_t)(lrow & (SEQ - 1)) * 128 + (e & 127); }
struct EpiH1 {
    const float* rs; const float* lbl; int layer_j; int row_base;
    bf16_t *QEF, *KIF, *QEB, *KIB, *VV; float *DLF, *DLB; bf16_t* SZ; RCtx rc;
    __device__ __forceinline__ void operator()(const f32x4 (&acc)[2][2][4][2], const pg8::Unit& u, int wr, int wc, int fr, int fq) const {
        if (u.pn >= 32) {
            float rz[2][4]; row_rscale8c(rc, rs, row_base + u.pm * 256 + wr * 64 + fr, u.pm, wr * 64 + fr, fq, rz);
            bf16_t* base = SZ + (size_t)(u.pm * 256 + wr * 64 + fr) * EI + (u.pn - 32) * 256 + wc * 32 + fq * 4;
#pragma unroll
            for (int ai = 0; ai < 2; ++ai)
#pragma unroll
                for (int m = 0; m < 4; ++m)
#pragma unroll
                    for (int bj = 0; bj < 2; ++bj) {
                        u32x2 wn[2];
#pragma unroll
                        for (int n = 0; n < 2; ++n) {
                            const f32x4 z = acc[ai][bj][m][n] * rz[ai][m];
                            const float y0 = z[0] * fast_rcp(1.0f + fast_exp(-z[0])), y1 = z[1] * fast_rcp(1.0f + fast_exp(-z[1]));
                            const float y2 = z[2] * fast_rcp(1.0f + fast_exp(-z[2])), y3 = z[3] * fast_rcp(1.0f + fast_exp(-z[3]));
                            wn[n].x = cvt_pk_bf16(y0, y1); wn[n].y = cvt_pk_bf16(y2, y3);
                        }
                        bf16_t* q = base + (size_t)(ai * 128 + m * 16) * EI + bj * 128;
                        store_pair16(q, q + 16, wn[0], wn[1], fq);
                    }
            return;
        }
        const int e0 = u.pn * 64 + wc * 16 + fq * 4;
        float oml[4];
#pragma unroll
        for (int j = 0; j < 4; ++j) {
            float lb = 0.f;
            if (layer_j == 1) { const float l0 = lbl[e0 + j], l1 = lbl[EI + e0 + j], mx = fmaxf(l0, l1), a0 = __expf(l0 - mx), a1 = __expf(l1 - mx), sm = a0 + a1, p0 = a0 / sm, p1 = a1 / sm; lb = (p0 + p1) - p0; }
            lb = fminf(fmaxf(lb, 0.f), 1.0f - 1e-6f);
            oml[j] = 1.0f - lb;
        }
        const float qscale = 0.08838834764831845f;
        float rsc[2][4]; row_rscale8c(rc, rs, row_base + u.pm * 256 + wr * 64 + fr, u.pm, wr * 64 + fr, fq, rsc);
#pragma unroll
        for (int ai = 0; ai < 2; ++ai)
#pragma unroll
            for (int mm = 0; mm < 2; ++mm) {
                const int m0 = 2 * mm, m1 = 2 * mm + 1;
                const int lrow0 = u.pm * 256 + ai * 128 + wr * 64 + m0 * 16 + fr, lrow1 = lrow0 + 16;
                const float r0 = rsc[ai][m0], r1 = rsc[ai][m1], r0l = r0 * 1.44269504089f, r1l = r1 * 1.44269504089f;
                float qf0[4], qf1[4], kf0[4], kf1[4], qb0[4], qb1[4], kb0[4], kb1[4], dlf[4], dlb[4];
#pragma unroll
                for (int j = 0; j < 4; ++j) {
                    const float q0 = acc[ai][0][m0][0][j] * (r0 * qscale), q1 = acc[ai][0][m1][0][j] * (r1 * qscale);
                    {
                        const float k0 = oml[j] * fast_rcp(1.0f + fast_exp2(acc[ai][0][m0][1][j] * r0l)), k1 = oml[j] * fast_rcp(1.0f + fast_exp2(acc[ai][0][m1][1][j] * r1l));
                        const float e0_ = row_prefprod16(1.0f - k0); const float e1_ = row_prefprod16(1.0f - k1) * dppf<0x15f>(e0_);
                        const float E0 = fmaxf(e0_, 1e-30f), E1 = fmaxf(e1_, 1e-30f);
                        qf0[j] = q0 * E0; qf1[j] = q1 * E1; kf0[j] = k0 * fast_rcp(E0); kf1[j] = k1 * fast_rcp(E1);
                        dlf[j] = E1;
                    }
                    {
                        const float k0 = oml[j] * fast_rcp(1.0f + fast_exp2(acc[ai][1][m0][0][j] * r0l)), k1 = oml[j] * fast_rcp(1.0f + fast_exp2(acc[ai][1][m1][0][j] * r1l));
                        const float e1_ = row_sufprod16(1.0f - k1); const float e0_ = row_sufprod16(1.0f - k0) * dppf<0x150>(e1_);
                        const float E0 = fmaxf(e0_, 1e-30f), E1 = fmaxf(e1_, 1e-30f);
                        qb0[j] = q0 * E0; qb1[j] = q1 * E1; kb0[j] = k0 * fast_rcp(E0); kb1[j] = k1 * fast_rcp(E1);
                        dlb[j] = E0;
                    }
                }
                const size_t o0 = hm_off(lrow0, e0), o1 = o0 + 16 * 128;
                u32x2 wa, wb;
                wa.x = cvt_pk_bf16(qf0[0], qf0[1]); wa.y = cvt_pk_bf16(qf0[2], qf0[3]); wb.x = cvt_pk_bf16(kf0[0], kf0[1]); wb.y = cvt_pk_bf16(kf0[2], kf0[3]); store_pair16(QEF + o0, KIF + o0, wa, wb, fq);
                wa.x = cvt_pk_bf16(qf1[0], qf1[1]); wa.y = cvt_pk_bf16(qf1[2], qf1[3]); wb.x = cvt_pk_bf16(kf1[0], kf1[1]); wb.y = cvt_pk_bf16(kf1[2], kf1[3]); store_pair16(QEF + o1, KIF + o1, wa, wb, fq);
                wa.x = cvt_pk_bf16(qb0[0], qb0[1]); wa.y = cvt_pk_bf16(qb0[2], qb0[3]); wb.x = cvt_pk_bf16(kb0[0], kb0[1]); wb.y = cvt_pk_bf16(kb0[2], kb0[3]); store_pair16(QEB + o0, KIB + o0, wa, wb, fq);
                wa.x = cvt_pk_bf16(qb1[0], qb1[1]); wa.y = cvt_pk_bf16(qb1[2], qb1[3]); wb.x = cvt_pk_bf16(kb1[0], kb1[1]); wb.y = cvt_pk_bf16(kb1[2], kb1[3]); store_pair16(QEB + o1, KIB + o1, wa, wb, fq);
                const f32x4 i0 = acc[ai][1][m0][1] * r0, i1 = acc[ai][1][m1][1] * r1;
                wa.x = cvt_pk_bf16(i0[0], i0[1]); wa.y = cvt_pk_bf16(i0[2], i0[3]); wb.x = cvt_pk_bf16(i1[0], i1[1]); wb.y = cvt_pk_bf16(i1[2], i1[3]); store_pair16(VV + o0, VV + o1, wa, wb, fq);
                const size_t oc = (size_t)(lrow0 >> 5) * EI + e0;
                if (fr == 15) *(f32x4*)(DLF + oc) = (f32x4){dlf[0], dlf[1], dlf[2], dlf[3]};
                if (fr == 0) *(f32x4*)(DLB + oc) = (f32x4){dlb[0], dlb[1], dlb[2], dlb[3]};
            }
    }
};

struct EpiSZ {
    const float* rs; int row_base; bf16_t* SZ; RCtx rc;
    __device__ __forceinline__ void operator()(const f32x4 (&acc)[2][2][4][2], const pg8::Unit& u, int wr, int wc, int fr, int fq) const {
            float rz[2][4]; row_rscale8c(rc, rs, row_base + u.pm * 256 + wr * 64 + fr, u.pm, wr * 64 + fr, fq, rz);
            bf16_t* base = SZ + (size_t)(u.pm * 256 + wr * 64 + fr) * EI + u.pn * 256 + wc * 32 + fq * 4;
#pragma unroll
            for (int ai = 0; ai < 2; ++ai)
#pragma unroll
                for (int m = 0; m < 4; ++m)
#pragma unroll
                    for (int bj = 0; bj < 2; ++bj) {
                        u32x2 wn[2];
#pragma unroll
                        for (int n = 0; n < 2; ++n) {
                            const f32x4 z = acc[ai][bj][m][n] * rz[ai][m];
                            const float y0 = z[0] * fast_rcp(1.0f + fast_exp(-z[0])), y1 = z[1] * fast_rcp(1.0f + fast_exp(-z[1]));
                            const float y2 = z[2] * fast_rcp(1.0f + fast_exp(-z[2])), y3 = z[3] * fast_rcp(1.0f + fast_exp(-z[3]));
                            wn[n].x = cvt_pk_bf16(y0, y1); wn[n].y = cvt_pk_bf16(y2, y3);
                        }
                        bf16_t* q = base + (size_t)(ai * 128 + m * 16) * EI + bj * 128;
                        store_pair16(q, q + 16, wn[0], wn[1], fq);
                    }
    }
};

__device__ __forceinline__ int perm_col(int col) {
    const int type = col >> 11, e = col & 2047;
    return (e >> 6) * 256 + (type >> 1) * 128 + ((e >> 4) & 3) * 32 + (type & 1) * 16 + ((e >> 2) & 3) * 4 + (e & 3);
}
struct TileDesc { const float* src; const float* nw; bf16_t* dst; int ld_src, ld_dst, k0, c0, perm_limit; };
struct Params {
    const float* x; const float* norm_w; const float* final_norm_w; const float* conv_w_in; const float* conv_kernel; const float* conv_w_out;
    const float* hgrn_w_in; const float* hgrn_lb; const float* hgrn_norm_w; const float* hgrn_w_out;
    float* out; unsigned char* ws; int never; int pad;
};
__device__ __forceinline__ TileDesc tile_desc(const Params& P, int t) {
    TileDesc d;
    if (t < 4096) { const int l = t >> 11, r = t & 2047, kt = r >> 7, ct = r & 127;
        d.src = P.conv_w_in + (size_t)l * DM * 8192; d.ld_src = 8192; d.k0 = kt * 64; d.c0 = ct * 64; d.nw = P.norm_w + (size_t)(2 * l) * DM; d.dst = (bf16_t*)(P.ws + WS_WCIN) + (size_t)l * 8192 * DM; d.ld_dst = DM; d.perm_limit = 8192;
    } else if (t < 4096 + 5120) { const int q = t - 4096, l = q / 2560, r = q % 2560, kt = r / 160, ct = r % 160;
        d.src = P.hgrn_w_in + (size_t)l * DM * 10240; d.ld_src = 10240; d.k0 = kt * 64; d.c0 = ct * 64; d.nw = P.norm_w + (size_t)(2 * l + 1) * DM; d.dst = (bf16_t*)(P.ws + WS_WHIN) + (size_t)l * 10240 * DM; d.ld_dst = DM; d.perm_limit = 8192;
    } else if (t < 4096 + 5120 + 1024) { const int q = t - 9216, l = q >> 9, r = q & 511, kt = r >> 4, ct = r & 15;
        d.src = P.conv_w_out + (size_t)l * EI * DM; d.ld_src = DM; d.k0 = kt * 64; d.c0 = ct * 64; d.nw = nullptr; d.dst = (bf16_t*)(P.ws + WS_WCOUT) + (size_t)l * DM * EI; d.ld_dst = EI; d.perm_limit = 0;
    } else { const int q = t - 10240, l = q >> 9, r = q & 511, kt = r >> 4, ct = r & 15;
        d.src = P.hgrn_w_out + (size_t)l * EI * DM; d.ld_src = DM; d.k0 = kt * 64; d.c0 = ct * 64; d.nw = nullptr; d.dst = (bf16_t*)(P.ws + WS_WHOUT) + (size_t)l * DM * EI; d.ld_dst = EI; d.perm_limit = 0;
    }
    return d;
}

__device__ __forceinline__ void prologue(const Params& P, LAS unsigned char* lds) {
    LAS float* tiles = (LAS float*)lds;
    const int G = gridDim.x, bid = blockIdx.x, tid = threadIdx.x;
    constexpr int NT = 4096 + 5120 + 1024 + 1024, NG = NT / 4;
    for (int grp = bid; grp < NG; grp += G) {
        f32x4 v[4][2];
        const int rr = tid >> 4, cc = (tid & 15) * 4;
#pragma unroll
        for (int q = 0; q < 4; ++q) { const TileDesc d = tile_desc(P, grp * 4 + q);
#pragma unroll
            for (int p = 0; p < 2; ++p) v[q][p] = *(const f32x4*)(d.src + (size_t)(d.k0 + rr + 32 * p) * d.ld_src + d.c0 + cc); }
#pragma unroll
        for (int q = 0; q < 4; ++q)
#pragma unroll
            for (int p = 0; p < 2; ++p) { LAS float* t = tiles + q * (64 * 65) + (rr + 32 * p) * 65 + cc; t[0] = v[q][p][0]; t[1] = v[q][p][1]; t[2] = v[q][p][2]; t[3] = v[q][p][3]; }
        __syncthreads();
        const int c = tid >> 3, ks = (tid & 7) * 8;
#pragma unroll
        for (int q = 0; q < 4; ++q) { const TileDesc d = tile_desc(P, grp * 4 + q);
            float w8[8];
#pragma unroll
            for (int i = 0; i < 8; ++i) { w8[i] = tiles[q * (64 * 65) + (ks + i) * 65 + c]; if (d.nw) w8[i] *= d.nw[d.k0 + ks + i]; }
            const int col = d.c0 + c, drow = (col < d.perm_limit) ? perm_col(col) : col;
            u32x4 w; w.x = cvt_pk_bf16(w8[0], w8[1]); w.y = cvt_pk_bf16(w8[2], w8[3]); w.z = cvt_pk_bf16(w8[4], w8[5]); w.w = cvt_pk_bf16(w8[6], w8[7]);
            *(u32x4*)(d.dst + (size_t)drow * d.ld_dst + d.k0 + ks) = w; }
        __syncthreads();
    }
    const int lane = tid & 63, gw = bid * 8 + (tid >> 6), nw_ = G * 8;
    bf16_t* xb = (bf16_t*)(P.ws + WS_XB); float* rs = (float*)(P.ws + WS_RS);
    for (int row = gw; row < MT; row += 2 * nw_) {
        f32x4 v[2][4];
#pragma unroll
        for (int q = 0; q < 2; ++q)
#pragma unroll
            for (int i = 0; i < 4; ++i) v[q][i] = *(const f32x4*)(P.x + (size_t)(row + q * nw_) * DM + i * 256 + lane * 4);
#pragma unroll
        for (int q = 0; q < 2; ++q) {
            float ss = 0.f;
#pragma unroll
            for (int i = 0; i < 4; ++i) {
                const f32x4 a = v[q][i];
                ss += (a[0] * a[0] + a[1] * a[1]) + (a[2] * a[2] + a[3] * a[3]);
                u32x2 w; w.x = cvt_pk_bf16(a[0], a[1]); w.y = cvt_pk_bf16(a[2], a[3]); *(u32x2*)(xb + (size_t)(row + q * nw_) * DM + i * 256 + lane * 4) = w;
            }
#pragma unroll
            for (int o = 32; o >= 1; o >>= 1) ss += __shfl_xor(ss, o);
            if (lane < 16) rs[(size_t)lane * MT + row + q * nw_] = lane == 0 ? ss : 0.f;
        }
    }
}

__device__ __forceinline__ void conv_fix(bf16_t* Y, bf16_t* Yhi, const bf16_t* __restrict__ VE, const bf16_t* __restrict__ GE, const float* __restrict__ ck  ) {
    const int nthreads = gridDim.x * 512; constexpr int NBLK = MT / 64;
    for (int task = blockIdx.x * 512 + threadIdx.x; task < (NBLK + 1) * 256; task += nthreads) {
        const int ec = task & 255, B = task >> 8, e0 = ec * 8, t = 64 * B;
        const bool seqb = (t & (SEQ - 1)) == 0, hasp = B > 0, hasn = B < NBLK;
        const u32x4 zero = (u32x4){0u, 0u, 0u, 0u};
        u32x4 va = zero, vb = zero, gb = zero, vc = zero, vd = zero, gc = zero;
        if (hasp) { va = *(const u32x4*)(VE + ((size_t)(B - 1) * 4 + 0) * EI + e0); vb = *(const u32x4*)(VE + ((size_t)(B - 1) * 4 + 1) * EI + e0); gb = *(const u32x4*)(GE + ((size_t)(B - 1) * 2 + 0) * EI + e0); }
        if (hasn) { vc = *(const u32x4*)(VE + ((size_t)B * 4 + 2) * EI + e0); vd = *(const u32x4*)(VE + ((size_t)B * 4 + 3) * EI + e0); gc = *(const u32x4*)(GE + ((size_t)B * 2 + 1) * EI + e0); }
        float k0[8], k1[8], k2[8];
#pragma unroll
        for (int i = 0; i < 8; ++i) { k0[i] = ck[e0 + i]; k1[i] = ck[EI + e0 + i]; k2[i] = ck[2 * EI + e0 + i]; }
        const u32x4 vcn = seqb ? zero : vc, vbp = seqb ? zero : vb;
        float y1[8], y2[8];
#pragma unroll
        for (int h = 0; h < 4; ++h) {
            y1[2 * h] = bflo(gb[h]) * (k0[2 * h] * bflo(va[h]) + k1[2 * h] * bflo(vb[h]) + k2[2 * h] * bflo(vcn[h]));
            y1[2 * h + 1] = bfhi(gb[h]) * (k0[2 * h + 1] * bfhi(va[h]) + k1[2 * h + 1] * bfhi(vb[h]) + k2[2 * h + 1] * bfhi(vcn[h]));
            y2[2 * h] = bflo(gc[h]) * (k0[2 * h] * bflo(vbp[h]) + k1[2 * h] * bflo(vc[h]) + k2[2 * h] * bflo(vd[h]));
            y2[2 * h + 1] = bfhi(gc[h]) * (k0[2 * h + 1] * bfhi(vbp[h]) + k1[2 * h + 1] * bfhi(vc[h]) + k2[2 * h + 1] * bfhi(vd[h]));
        }
        if (hasp) { u32x4 w; w.x = cvt_pk_bf16(y1[0], y1[1]); w.y = cvt_pk_bf16(y1[2], y1[3]); w.z = cvt_pk_bf16(y1[4], y1[5]); w.w = cvt_pk_bf16(y1[6], y1[7]); *(u32x4*)(((t - 1 >= MH) ? Yhi : Y) + (size_t)(t - 1) * EI + e0) = w; }
        if (hasn) { u32x4 w; w.x = cvt_pk_bf16(y2[0], y2[1]); w.y = cvt_pk_bf16(y2[2], y2[3]); w.z = cvt_pk_bf16(y2[4], y2[5]); w.w = cvt_pk_bf16(y2[6], y2[7]); *(u32x4*)(((t >= MH) ? Yhi : Y) + (size_t)t * EI + e0) = w; }
    }
}

__device__ __forceinline__ unsigned offb(unsigned row, unsigned ch) { return 256u * row + 16u * (ch ^ (((row & 3u) << 2) | ((row >> 2) & 3u))); }
constexpr int SCAN_BUF = 8192 + 8192 + 8192 + 512;
constexpr int SCAN_XCH = 2 * SCAN_BUF;
__device__ __forceinline__ bf16x8 pack8(const f32x4 a, const f32x4 b) {
    u32x4 w; w.x = cvt_pk_bf16(a[0], a[1]); w.y = cvt_pk_bf16(a[2], a[3]); w.z = cvt_pk_bf16(b[0], b[1]); w.w = cvt_pk_bf16(b[2], b[3]);
    return __builtin_bit_cast(bf16x8, w);
}
__device__ __forceinline__ bf16x8 join8(u32x2 lo, u32x2 hi) { u32x4 w; w.x = lo.x; w.y = lo.y; w.z = hi.x; w.w = hi.y; return __builtin_bit_cast(bf16x8, w); }

__device__ __forceinline__ void scan_phase(LAS unsigned char* lds, bf16_t* QEF, const bf16_t* __restrict__ KIF, bf16_t* QEB, const bf16_t* __restrict__ KIB,
                                           const bf16_t* __restrict__ VV, const float* __restrict__ DLF, const float* __restrict__ DLB) {
    int tid = threadIdx.x; asm volatile("" : "+v"(tid));
    const int lane = tid & 63, w = __builtin_amdgcn_readfirstlane(tid >> 6), c = lane & 15, g = lane >> 4, kh = w >> 2, vq = w & 3;
    const unsigned lbase = (unsigned)(unsigned long long)lds;
    for (int item = blockIdx.x; item < 128; item += gridDim.x) {
        const int dir = item & 1, h = (item >> 1) & 15, b = item >> 5;
        bf16_t* QE = dir ? QEB : QEF; const bf16_t* KI = dir ? KIB : KIF; const float* DL = dir ? DLB : DLF;
        const int lrow = tid >> 4, lch = tid & 15;
        const size_t hbase = (size_t)b * ((size_t)EI * SEQ) + (size_t)h * ((size_t)SEQ * 128);
        const bf16_t* qk_src = ((lch < 8) ? (const bf16_t*)QE : KI) + hbase + (size_t)lrow * 128 + (lch & 7) * 8;
        const bf16_t* v_src = VV + hbase + (size_t)lrow * 128 + lch * 8;
        const float* dl_src = DL + (size_t)(b * (SEQ / 32)) * EI + h * 128 + (tid & 127);
        const unsigned st_qk = offb(lrow, lch), st_v = 16384u + offb(lrow, lch);
        const unsigned rq = (unsigned)(g >> 1);
        const unsigned rrow = (unsigned)c;
        const unsigned swz = ((rrow & 3u) << 2) | ((rrow >> 2) & 3u);
        const unsigned rowb = (unsigned)kh * 8192u + 256u * rrow + (unsigned)(g & 1) * 8u;
        const unsigned trow = 4u * (unsigned)g + ((unsigned)c >> 2), tp = (unsigned)c & 3u;
        const unsigned tr_v0 = 16384u + offb(trow, 2u * (unsigned)(2 * vq) + (tp >> 1)) + 8u * (tp & 1u);
        const unsigned tr_v1 = 16384u + offb(trow, 2u * (unsigned)(2 * vq + 1) + (tp >> 1)) + 8u * (tp & 1u);
        unsigned tr_k[4];
#pragma unroll
        for (int kt = 0; kt < 4; ++kt) tr_k[kt] = (unsigned)kh * 8192u + offb(trow, 2u * (unsigned)(4 + kt) + (tp >> 1)) + 8u * (tp & 1u);
        bf16_t* o_dst = QE + hbase + (size_t)c * 128 + vq * 32 + g * 4;
        const unsigned xchw = (unsigned)SCAN_XCH + (unsigned)kh * 16384u + (unsigned)vq * 4096u + (unsigned)lane * 16u;
        const unsigned xchr = (unsigned)SCAN_XCH + (unsigned)vq * 4096u + (unsigned)(kh * 2) * 1024u + (unsigned)lane * 16u;
        const unsigned dlo = 24576u + (unsigned)(kh * 64 + 4 * g) * 4u;

        f32x4 S[2][4];
#pragma unroll
        for (int vt = 0; vt < 2; ++vt) {
#pragma unroll
            for (int kt = 0; kt < 4; ++kt) S[vt][kt] = (f32x4){0.f, 0.f, 0.f, 0.f};
        }
#define SCAN_CI(s_) (dir ? 127 - ((s_) < 127 ? (s_) : 127) : ((s_) < 127 ? (s_) : 127))
#define SCAN_LOAD(cn_, P0, P1, PV, PD) do { P0 = __builtin_nontemporal_load((const u32x4*)(qk_src + (size_t)(cn_) * 32 * 128)); P1 = __builtin_nontemporal_load((const u32x4*)(qk_src + (size_t)(cn_) * 32 * 128 + 64)); \
            PV = __builtin_nontemporal_load((const u32x4*)(v_src + (size_t)(cn_) * 32 * 128)); if (tid < 128) PD = dl_src[(size_t)(cn_) * EI]; } while (0)
#define SCAN_PUT(bn_, P0, P1, PV, PD) do { *(LAS u32x4*)(lds + (bn_) + st_qk) = P0; *(LAS u32x4*)(lds + (bn_) + 8192u + st_qk) = P1; \
            *(LAS u32x4*)(lds + (bn_) + st_v) = PV; if (tid < 128) *(LAS float*)(lds + (bn_) + 24576u + tid * 4) = PD; } while (0)
        const u32x4 z4 = (u32x4){0u, 0u, 0u, 0u};
        u32x4 p0A = z4, p1A = z4, pvA = z4, p0B = z4, p1B = z4, pvB = z4, p0C = z4, p1C = z4, pvC = z4, p0D = z4, p1D = z4, pvD = z4; float pdA = 0.f, pdB = 0.f, pdC = 0.f, pdD = 0.f;
        {
            SCAN_LOAD(SCAN_CI(0), p0A, p1A, pvA, pdA); SCAN_LOAD(SCAN_CI(1), p0B, p1B, pvB, pdB); SCAN_LOAD(SCAN_CI(2), p0C, p1C, pvC, pdC); SCAN_LOAD(SCAN_CI(3), p0D, p1D, pvD, pdD);
            SCAN_PUT(0u, p0A, p1A, pvA, pdA);
        }
        __syncthreads();
#define SCAN_FLUSH(s_) do { const int cp = SCAN_CI((s_) - 1); const unsigned xo = xchr + (unsigned)(((s_) - 1) & 1) * 32768u; u32x2 wv[2]; \
            _Pragma("unroll") for (int pt = 0; pt < 2; ++pt) { const f32x4 o = *(const LAS f32x4*)(lds + xo + pt * 1024) + *(const LAS f32x4*)(lds + xo + 16384u + pt * 1024); \
                wv[pt].x = cvt_pk_bf16(o[0], o[1]); wv[pt].y = cvt_pk_bf16(o[2], o[3]); } \
            store_pair16(o_dst + (size_t)(cp * 32) * 128 + kh * 16, o_dst + (size_t)(cp * 32 + 16) * 128 + kh * 16, wv[0], wv[1], g); } while (0)
#define SCAN_STEP(s_, BO, BN, P0W, P1W, PVW, PDW, P0L, P1L, PVL, PDL) do { \
            const unsigned bo = (BO), bn = (BN); \
            SCAN_LOAD(SCAN_CI((s_) + 4), P0L, P1L, PVL, PDL); \
            bf16x8 qeB[2][2], kiA[2][2]; \
            _Pragma("unroll") for (int kk = 0; kk < 2; ++kk) { \
                const unsigned ch0 = (unsigned)(4 * kk) | rq, ch1 = ch0 | 2u; \
                const unsigned a0 = bo + rowb + 16u * (ch0 ^ swz), a1 = bo + rowb + 16u * (ch1 ^ swz); \
                const unsigned k0 = bo + rowb + 16u * ((ch0 | 8u) ^ swz), k1 = bo + rowb + 16u * ((ch1 | 8u) ^ swz); \
                _Pragma("unroll") for (int pt = 0; pt < 2; ++pt) { \
                    qeB[pt][kk] = join8(*(const LAS u32x2*)(lds + a0 + pt * 4096), *(const LAS u32x2*)(lds + a1 + pt * 4096)); \
                    kiA[pt][kk] = join8(*(const LAS u32x2*)(lds + k0 + pt * 4096), *(const LAS u32x2*)(lds + k1 + pt * 4096)); } } \
            u32x2 vlo[2], vhi[2], klo[4], khi[4]; \
            { const unsigned av0 = lbase + bo + tr_v0, av1 = lbase + bo + tr_v1, ak0 = lbase + bo + tr_k[0], ak1 = lbase + bo + tr_k[1], ak2 = lbase + bo + tr_k[2], ak3 = lbase + bo + tr_k[3]; \
              asm volatile("ds_read_b64_tr_b16 %0, %12\n\tds_read_b64_tr_b16 %1, %12 offset:4096\n\t" \
                           "ds_read_b64_tr_b16 %2, %13\n\tds_read_b64_tr_b16 %3, %13 offset:4096\n\t" \
                           "ds_read_b64_tr_b16 %4, %14\n\tds_read_b64_tr_b16 %5, %14 offset:4096\n\t" \
                           "ds_read_b64_tr_b16 %6, %15\n\tds_read_b64_tr_b16 %7, %15 offset:4096\n\t" \
                           "ds_read_b64_tr_b16 %8, %16\n\tds_read_b64_tr_b16 %9, %16 offset:4096\n\t" \
                           "ds_read_b64_tr_b16 %10, %17\n\tds_read_b64_tr_b16 %11, %17 offset:4096\n\t" \
                           "s_waitcnt lgkmcnt(0)" \
                           : "=&v"(vlo[0]), "=&v"(vhi[0]), "=&v"(vlo[1]), "=&v"(vhi[1]), "=&v"(klo[0]), "=&v"(khi[0]), "=&v"(klo[1]), "=&v"(khi[1]), "=&v"(klo[2]), "=&v"(khi[2]), "=&v"(klo[3]), "=&v"(khi[3]) \
                           : "v"(av0), "v"(av1), "v"(ak0), "v"(ak1), "v"(ak2), "v"(ak3) : "memory"); } \
            bf16x8 ATp[2]; \
            { f32x4 AT[2][2]; \
              _Pragma("unroll") for (int ut = 0; ut < 2; ++ut) _Pragma("unroll") for (int pt = 0; pt < 2; ++pt) { \
                f32x4 z = (f32x4){0.f, 0.f, 0.f, 0.f}; \
                z = __builtin_amdgcn_mfma_f32_16x16x32_bf16(kiA[ut][0], qeB[pt][0], z, 0, 0, 0); \
                z = __builtin_amdgcn_mfma_f32_16x16x32_bf16(kiA[ut][1], qeB[pt][1], z, 0, 0, 0); \
                _Pragma("unroll") for (int i = 0; i < 4; ++i) { const int uu = 16 * ut + 4 * g + i, pp = 16 * pt + c; const bool keep = dir ? (uu >= pp) : (uu <= pp); z[i] = keep ? z[i] : 0.f; } \
                AT[ut][pt] = z; } \
              ATp[0] = pack8(AT[0][0], AT[1][0]); ATp[1] = pack8(AT[0][1], AT[1][1]); } \
            _Pragma("unroll") for (int vt = 0; vt < 2; ++vt) { \
                const bf16x8 vT = join8(vlo[vt], vhi[vt]); \
                const bf16x8 Sf0 = pack8(S[vt][0], S[vt][1]), Sf1 = pack8(S[vt][2], S[vt][3]); \
                _Pragma("unroll") for (int pt = 0; pt < 2; ++pt) { \
                    f32x4 o = (f32x4){0.f, 0.f, 0.f, 0.f}; \
                    o = __builtin_amdgcn_mfma_f32_16x16x32_bf16(Sf0, qeB[pt][0], o, 0, 0, 0); \
                    o = __builtin_amdgcn_mfma_f32_16x16x32_bf16(Sf1, qeB[pt][1], o, 0, 0, 0); \
                    o = __builtin_amdgcn_mfma_f32_16x16x32_bf16(vT, ATp[pt], o, 0, 0, 0); \
                    *(LAS f32x4*)(lds + xchw + (unsigned)((s_) & 1) * 32768u + (vt * 2 + pt) * 1024) = o; } \
                _Pragma("unroll") for (int kt = 0; kt < 4; ++kt) { \
                    S[vt][kt] = __builtin_amdgcn_mfma_f32_16x16x32_bf16(join8(klo[kt], khi[kt]), vT, S[vt][kt], 0, 0, 0); \
                    S[vt][kt] = S[vt][kt] * *(const LAS f32x4*)(lds + bo + dlo + 64 * kt); } } \
            if ((s_) > 0) SCAN_FLUSH(s_);     \
            SCAN_PUT(bn, P0W, P1W, PVW, PDW); \
            __syncthreads(); } while (0)
        for (int s = 0; s < 128; s += 4) {
            SCAN_STEP(s, 0u, (unsigned)SCAN_BUF, p0B, p1B, pvB, pdB, p0A, p1A, pvA, pdA);
            SCAN_STEP(s + 1, (unsigned)SCAN_BUF, 0u, p0C, p1C, pvC, pdC, p0B, p1B, pvB, pdB);
            SCAN_STEP(s + 2, 0u, (unsigned)SCAN_BUF, p0D, p1D, pvD, pdD, p0C, p1C, pvC, pdC);
            SCAN_STEP(s + 3, (unsigned)SCAN_BUF, 0u, p0A, p1A, pvA, pdA, p0D, p1D, pvD, pdD);
        }
        SCAN_FLUSH(128);
        __syncthreads();
#undef SCAN_STEP
#undef SCAN_FLUSH
#undef SCAN_PUT
#undef SCAN_LOAD
#undef SCAN_CI
    }
}

__device__ __forceinline__ void combine_phase(const bf16_t* __restrict__ OF, const bf16_t* __restrict__ OB, const bf16_t* __restrict__ SZ, bf16_t* __restrict__ ON, const float* __restrict__ nw) {
    const int nthreads = gridDim.x * 512;
    for (int task0 = blockIdx.x * 512 + threadIdx.x; task0 < MH * 256; task0 += 2 * nthreads) {
        u32x4 a0[2], b0[2], zz[2];
#pragma unroll
        for (int q = 0; q < 2; ++q) {
            const int task = task0 + q * nthreads; const int cv = task & 15, tin = (task >> 4) & (SEQ - 1), hh = (task >> 16) & 15, bb = task >> 20;
            const size_t off = (size_t)bb * ((size_t)EI * SEQ) + (size_t)hh * ((size_t)SEQ * 128) + (size_t)tin * 128 + cv * 8;
            a0[q] = __builtin_nontemporal_load((const u32x4*)(OF + off)); b0[q] = __builtin_nontemporal_load((const u32x4*)(OB + off));
            zz[q] = __builtin_nontemporal_load((const u32x4*)(SZ + (size_t)(bb * SEQ + tin) * EI + hh * 128 + cv * 8));
        }
#pragma unroll
        for (int q = 0; q < 2; ++q) {
            const int task = task0 + q * nthreads; const int cv = task & 15, tin = (task >> 4) & (SEQ - 1), hh = (task >> 16) & 15, bb = task >> 20, t = bb * SEQ + tin;
            float o[8]; float ss = 0.f;
#pragma unroll
            for (int i = 0; i < 4; ++i) {
                o[2 * i] = bflo(a0[q][i]) + bflo(b0[q][i]);
                o[2 * i + 1] = bfhi(a0[q][i]) + bfhi(b0[q][i]);
                ss += o[2 * i] * o[2 * i] + o[2 * i + 1] * o[2 * i + 1];
            }
            ss += __shfl_xor(ss, 1); ss += __shfl_xor(ss, 2); ss += __shfl_xor(ss, 4); ss += __shfl_xor(ss, 8);
            const float r = rsqrtf(ss * (1.0f / 128.0f) + EPSV);
            const int e = hh * 128 + cv * 8;
            const f32x4 w0 = *(const f32x4*)(nw + e), w1 = *(const f32x4*)(nw + e + 4);
            u32x4 w; w.x = cvt_pk_bf16(o[0] * r * w0[0] * bflo(zz[q].x), o[1] * r * w0[1] * bfhi(zz[q].x)); w.y = cvt_pk_bf16(o[2] * r * w0[2] * bflo(zz[q].y), o[3] * r * w0[3] * bfhi(zz[q].y));
            w.z = cvt_pk_bf16(o[4] * r * w1[0] * bflo(zz[q].z), o[5] * r * w1[1] * bfhi(zz[q].z)); w.w = cvt_pk_bf16(o[6] * r * w1[2] * bflo(zz[q].w), o[7] * r * w1[3] * bfhi(zz[q].w));
            *(u32x4*)(ON + (size_t)t * EI + e) = w;
        }
    }
}

__device__ __forceinline__ void final_norm(const bf16_t* __restrict__ xb, float* __restrict__ out, const float* __restrict__ fw) {
    const int lane = threadIdx.x & 63, gw = blockIdx.x * 8 + (threadIdx.x >> 6), nw_ = gridDim.x * 8;
    f32x4 wv[4];
#pragma unroll
    for (int i = 0; i < 4; ++i) wv[i] = *(const f32x4*)(fw + i * 256 + lane * 4);
    for (int row = gw; row < MT; row += 2 * nw_) {
        u32x2 v[2][4];
#pragma unroll
        for (int q = 0; q < 2; ++q)
#pragma unroll
            for (int i = 0; i < 4; ++i) v[q][i] = *(const u32x2*)(xb + (size_t)(row + q * nw_) * DM + i * 256 + lane * 4);
#pragma unroll
        for (int q = 0; q < 2; ++q) {
            f32x4 f[4]; float ss = 0.f;
#pragma unroll
            for (int i = 0; i < 4; ++i) { f[i] = (f32x4){bflo(v[q][i].x), bfhi(v[q][i].x), bflo(v[q][i].y), bfhi(v[q][i].y)}; ss += (f[i][0] * f[i][0] + f[i][1] * f[i][1]) + (f[i][2] * f[i][2] + f[i][3] * f[i][3]); }
#pragma unroll
            for (int o = 32; o >= 1; o >>= 1) ss += __shfl_xor(ss, o);
            const float r = rsqrtf(ss * (1.0f / DM) + EPSV);
#pragma unroll
            for (int i = 0; i < 4; ++i) *(f32x4*)(out + (size_t)(row + q * nw_) * DM + i * 256 + lane * 4) = f[i] * r * wv[i];
        }
    }
}


#define XB_TMO      128
#define XB_XCNT(j)  (256  + 64 * (j))
#define XB_XSUB(j)  (1280 + 64 * (j))
#define XB_XGEN(j)  (2304 + 64 * (j))
#define XB_TOP      3328
#define XB_TOPGEN   3392
#define XCD_BAR_WORDS 3456
#define XB_SPIN_CAP (1u << 18)
__device__ __forceinline__ unsigned xb_ld(unsigned* p)              { return __hip_atomic_load(p, __ATOMIC_RELAXED, __HIP_MEMORY_SCOPE_AGENT); }
__device__ __forceinline__ unsigned xb_add(unsigned* p, unsigned v) { return __hip_atomic_fetch_add(p, v, __ATOMIC_RELAXED, __HIP_MEMORY_SCOPE_AGENT); }
__device__ __forceinline__ unsigned xb_xcc_id() { return (unsigned)__builtin_amdgcn_s_getreg((3 << 11) | 20) & 0xFu; }
#define XB_SPIN(cond, bar) do { unsigned _sp = 0; while (cond) { __builtin_amdgcn_s_sleep(1); \
    if ((++_sp & 255u) == 0u) { if (xb_ld(&(bar)[XB_TMO])) break; if (_sp > XB_SPIN_CAP) { atomicAdd(&(bar)[XB_TMO], 1u); break; } } } } while (0)
struct XcdBarrier { unsigned* bar; unsigned x; volatile LAS unsigned* st; };
__device__ __forceinline__ XcdBarrier xcd_barrier_post(unsigned* bar, volatile LAS unsigned* st) {
    XcdBarrier b; b.bar = bar; b.x = xb_xcc_id(); b.st = st;
    if (threadIdx.x == 0) (void)xb_add(&bar[XB_XCNT(b.x)], 1u);
    return b;
}
__device__ __forceinline__ void xcd_barrier_complete(unsigned* bar, unsigned x, unsigned& nloc, unsigned& nx) {
    const unsigned G = gridDim.x * gridDim.y * gridDim.z;
    unsigned sum, cnt, mine, sp = 0u;
    for (;;) {
        sum = 0u; cnt = 0u; mine = 0u;
#pragma unroll
        for (unsigned j = 0; j < 16; ++j) { const unsigned c = xb_ld(&bar[XB_XCNT(j)]); sum += c; cnt += (c > 0u) ? 1u : 0u; mine = (j == x) ? c : mine; }
        if (sum == G) break;
        __builtin_amdgcn_s_sleep(1);
        if ((++sp & 255u) == 0u) { if (xb_ld(&bar[XB_TMO])) break; if (sp > XB_SPIN_CAP) { atomicAdd(&bar[XB_TMO], 1u); break; } }
    }
    nloc = mine > 0u ? mine : 1u; nx = cnt > 0u ? cnt : 1u;
}
__device__ __forceinline__ void xcd_barrier(const XcdBarrier& b) {
    asm volatile("s_waitcnt vmcnt(0)" ::: "memory");
    __syncthreads();
    if (threadIdx.x == 0) {
        unsigned* bar = b.bar;
        __builtin_amdgcn_s_waitcnt(0);
        unsigned nloc = b.st[0], nx = b.st[1];
        if (nloc == 0u) { xcd_barrier_complete(bar, b.x, nloc, nx); b.st[0] = nloc; b.st[1] = nx; }
        const unsigned old = xb_add(&bar[XB_XSUB(b.x)], 1u);
        const unsigned gen = old / nloc;
        if (old + 1u == (gen + 1u) * nloc) {
            __builtin_amdgcn_fence(__ATOMIC_RELEASE, "agent");
            asm volatile("s_waitcnt vmcnt(0)" ::: "memory");
            const unsigned og = xb_add(&bar[XB_TOP], 1u);
            const unsigned tg = og / nx;
            if (og + 1u == (tg + 1u) * nx) xb_add(&bar[XB_TOPGEN], 1u);
            else XB_SPIN(xb_ld(&bar[XB_TOPGEN]) == tg, bar);
            __builtin_amdgcn_fence(__ATOMIC_ACQUIRE, "agent");
            xb_add(&bar[XB_XGEN(b.x)], 1u);
            asm volatile("s_waitcnt vmcnt(0)" ::: "memory");
        } else {
            XB_SPIN(xb_ld(&bar[XB_XGEN(b.x)]) == gen, bar);
            __builtin_amdgcn_fence(__ATOMIC_ACQUIRE, "agent");
            asm volatile("s_waitcnt vmcnt(0)" ::: "memory");
        }
    }
    __syncthreads();
}

__device__ __forceinline__ void grid_barrier(cg::grid_group& grid) {
    asm volatile("s_waitcnt vmcnt(0) lgkmcnt(0)" ::: "memory");
    grid.sync();
    __builtin_amdgcn_fence(__ATOMIC_ACQUIRE, "agent");
    asm volatile("s_waitcnt vmcnt(0)" ::: "memory");
}
__global__ void __launch_bounds__(512, 2) fwd_megakernel(Params P) {
    extern __shared__ __attribute__((aligned(16))) unsigned char lds_raw[];
    LAS unsigned char* lds = (LAS unsigned char*)lds_raw;
    cg::grid_group grid = cg::this_grid();
    const int G = gridDim.x, bid = blockIdx.x;
    unsigned char* ws = P.ws;
    bf16_t* xb = (bf16_t*)(ws + WS_XB); float* rs = (float*)(ws + WS_RS);

    volatile LAS unsigned* xbst = (volatile LAS unsigned*)(lds + pg8::STAGE_BYTES);
    if (threadIdx.x == 0) { xbst[0] = 0u; xbst[1] = 0u; xbst[2] = 0u; xbst[3] = 0u; }
    __syncthreads();
    const XcdBarrier xbar = xcd_barrier_post((unsigned*)(ws + WS_BAR), xbst);
    prologue(P, lds);
    if (P.never) grid_barrier(grid);
    xcd_barrier(xbar);

#pragma nounroll
    for (int layer = 0; layer < DBG_LAYERS; ++layer) {
        const int j = layer >> 1;
        if ((layer & 1) == 0) {
            bf16_t* VE = (bf16_t*)(ws + WS_CV); bf16_t* GE = (bf16_t*)(ws + WS_CV + 16 * MiB); bf16_t* Gb = (bf16_t*)(ws + WS_CG);
            {
                pg8::Gemm g{xb, (const bf16_t*)(ws + WS_WCIN) + (size_t)j * 8192 * DM, MT, 8192, DM}; pg8::StaticOrder S; S.init(MT, 8192, G, bid);
                const RCtx rc = fill_row_scales(lds, S, rs, 0);
                EpiConv1 E{rs, Gb, VE, GE, P.conv_kernel + (size_t)j * 3 * EI, rc, (bf16_t*)P.out};
                pg8::gemm_phase<EpiConv1>(lds, g, S, E);
            }
            xcd_barrier(xbar);
            conv_fix(Gb, (bf16_t*)P.out, VE, GE, P.conv_kernel + (size_t)j * 3 * EI);
            xcd_barrier(xbar);
            {
                pg8::Gemm g{Gb, (const bf16_t*)(ws + WS_WCOUT) + (size_t)j * DM * EI, MH, DM, EI}; pg8::StaticOrder S; S.init(MH, DM, G, bid);
                EpiRes E{xb, rs, 0};
                pg8::gemm_phase<EpiRes>(lds, g, S, E);
            }
            xcd_barrier(xbar);
        } else {
            bf16_t* QEF = (bf16_t*)(ws + WS_QEF); bf16_t* KIF = (bf16_t*)(ws + WS_KIF); bf16_t* QEB = (bf16_t*)(ws + WS_QEB); bf16_t* KIB = (bf16_t*)(ws + WS_KIB); bf16_t* VV = (bf16_t*)(ws + WS_VV);
            float* DLF = (float*)(ws + WS_DLF); float* DLB = (float*)(ws + WS_DLB);
            bf16_t* Y0 = (bf16_t*)P.out + (size_t)MH * EI;
            const bf16_t* Win = (const bf16_t*)(ws + WS_WHIN) + (size_t)j * 10240 * DM;
#pragma nounroll
            for (int half = 0; half < 2; ++half) {
                const int rb = half * MH;
                {
                    pg8::Gemm g{xb + (size_t)rb * DM, Win, MH, 8192, DM}; pg8::StaticOrder S; S.init(MH, 8192, G, bid);
                    const RCtx rc = fill_row_scales(lds, S, rs, rb);
                    EpiH1 E{rs, P.hgrn_lb, j, rb, QEF, KIF, QEB, KIB, VV, DLF, DLB, (bf16_t*)P.out, rc};
                    pg8::gemm_phase<EpiH1>(lds, g, S, E);
                }
                xcd_barrier(xbar);
                if (bid < 128 || G < 256) {
                    scan_phase(lds, QEF, KIF, QEB, KIB, VV, DLF, DLB);
                }
                if (bid >= 128 || G < 256) {
                    const int Gz = (G < 256) ? G : G - 128, cz = (G < 256) ? bid : bid - 128;
                    pg8::Gemm g{xb + (size_t)rb * DM, Win + (size_t)8192 * DM, MH, EI, DM}; pg8::StaticOrder S; S.init(MH, EI, Gz, cz, (G < 256) ? 8 : 4);
                    const RCtx rc = fill_row_scales(lds, S, rs, rb);
                    EpiSZ E{rs, rb, (bf16_t*)P.out, rc};
                    pg8::gemm_phase<EpiSZ>(lds, g, S, E);
                    if (half == 0) {
                        pg8::Gemm g2{(const bf16_t*)P.out + (size_t)MH * EI, (const bf16_t*)(ws + WS_WCOUT) + (size_t)j * DM * EI, MH, DM, EI}; pg8::StaticOrder S2; S2.init(MH, DM, Gz, cz, (G < 256) ? 8 : 4);
                        EpiRes E2{xb, rs, MH};
                        pg8::gemm_phase<EpiRes>(lds, g2, S2, E2);
                    }
                    if (half == 1) {
                        pg8::Gemm g2{Y0, (const bf16_t*)(ws + WS_WHOUT) + (size_t)j * DM * EI, MH, DM, EI}; pg8::StaticOrder S2; S2.init(MH, DM, Gz, cz, (G < 256) ? 8 : 4);
                        EpiRes E2{xb, rs, 0};
                        pg8::gemm_phase<EpiRes>(lds, g2, S2, E2);
                    }
                }
                xcd_barrier(xbar);
                combine_phase(QEF, QEB, (const bf16_t*)P.out, (half == 0) ? Y0 : VV, P.hgrn_norm_w + (size_t)j * EI);
                xcd_barrier(xbar);
                if (half == 1) {
                    pg8::Gemm g{VV, (const bf16_t*)(ws + WS_WHOUT) + (size_t)j * DM * EI, MH, DM, EI}; pg8::StaticOrder S; S.init(MH, DM, G, bid);
                    EpiRes E{xb, rs, rb};
                    pg8::gemm_phase<EpiRes>(lds, g, S, E);
                    xcd_barrier(xbar);
                }
            }
        }
    }
    if (DBG_LAYERS == 0) { const size_t n = (size_t)MT * DM; for (size_t i = (size_t)blockIdx.x * 512 + threadIdx.x; i < n; i += (size_t)gridDim.x * 512) P.out[i] = P.x[i]; xcd_barrier(xbar); }
    final_norm(xb, P.out, P.final_norm_w);
}

extern "C" void kernel_launch(void* const* d_in, const int* in_sizes, int n_in, void* d_out, int out_size, void* d_ws, size_t ws_size, hipStream_t stream) {
    constexpr size_t kDynLds = pg8::STAGE_BYTES + 16 + 2048;
    static int grid_blocks = 0;
    if (!grid_blocks) {
        if (ws_size < WS_END) { fprintf(stderr, "kernel_launch: workspace too small: %zu < %zu\n", ws_size, (size_t)WS_END); grid_blocks = -1; return; }
        int dev = 0, cus = 0, per_cu = 0;
        hipGetDevice(&dev);
        hipDeviceGetAttribute(&cus, hipDeviceAttributeMultiprocessorCount, dev);
        if (hipFuncSetAttribute((const void*)fwd_megakernel, hipFuncAttributeMaxDynamicSharedMemorySize, (int)kDynLds) != hipSuccess) { fprintf(stderr, "kernel_launch: hipFuncSetAttribute failed\n"); grid_blocks = -1; return; }
        hipOccupancyMaxActiveBlocksPerMultiprocessor(&per_cu, (const void*)fwd_megakernel, 512, kDynLds);
        if (per_cu < 1) per_cu = 1;
        grid_blocks = cus * per_cu;
        if (grid_blocks > 256) grid_blocks = 256;
        (void)hipGetLastError();
    }
    if (grid_blocks < 0) return;
    if (hipMemsetAsync((char*)d_ws + WS_BAR, 0, 16384, stream) != hipSuccess) { fprintf(stderr, "kernel_launch: memset of barrier words failed\n"); return; }
    Params p{};
    p.x = (const float*)d_in[0]; p.norm_w = (const float*)d_in[1]; p.final_norm_w = (const float*)d_in[2]; p.conv_w_in = (const float*)d_in[3]; p.conv_kernel = (const float*)d_in[4];
    p.conv_w_out = (const float*)d_in[5]; p.hgrn_w_in = (const float*)d_in[6]; p.hgrn_lb = (const float*)d_in[7]; p.hgrn_norm_w = (const float*)d_in[8]; p.hgrn_w_out = (const float*)d_in[9];
    p.out = (float*)d_out; p.ws = (unsigned char*)d_ws;
    void* args[] = {&p};
    hipError_t e = hipLaunchCooperativeKernel((void*)fwd_megakernel, dim3(grid_blocks), dim3(512), args, kDynLds, stream);
    if (e != hipSuccess) fprintf(stderr, "cooperative launch failed: %s (grid %d)\n", hipGetErrorString(e), grid_blocks);
}
```
